# Optimizing an MI355X kernel written in HIP

```python
import math, functools
import jax, jax.numpy as jnp
from jax import lax
import numpy as np

D_MODEL = 1024
BATCH = 8
SEQ = 4096
DEPTH = 1

CHUNK = 64
DN_HEADS = 8
DN_HEAD_DIM = 64
DN_WIDTH = DN_HEADS * DN_HEAD_DIM
CONV_WIDTH = 4
POOL_GROUPS = 4
POOL_WINDOWS = (2, 4, 8, 16)
POOL_WIDTH = D_MODEL // 2
POOL_GROUP_DIM = POOL_WIDTH // POOL_GROUPS
N_BRANCH = 2
IN_WIDTH = 3 * DN_WIDTH + DN_WIDTH + 2 * DN_HEADS + POOL_WIDTH + N_BRANCH * D_MODEL
N_EXPERTS = 32
TOP_K = 4
D_FF = D_MODEL
SWIGLU_LIMIT = 7.0
SWIGLU_ALPHA = 1.702
NORM_EPS = 1e-6

kernel_name = "hybrid_deltanet_pool_moe_block"


def rms_norm(x, g):
    xf = x.astype(jnp.float32)
    y = xf * lax.rsqrt(jnp.mean(xf * xf, axis=-1, keepdims=True) + NORM_EPS)
    return (y * g.astype(jnp.float32)).astype(x.dtype)


def l2_normalize(t):
    return t * lax.rsqrt(jnp.sum(t * t, axis=-1, keepdims=True) + NORM_EPS)


def causal_depthwise_conv(u, w):
    K = w.shape[0]
    L = u.shape[1]
    up = jnp.pad(u, ((0, 0), (K - 1, 0), (0, 0)))
    return sum(up[:, j:j + L] * w[j] for j in range(K))


def chunked_gated_delta_rule(q, k, v, beta, g):
    B, H, L, dk = q.shape
    dv = v.shape[-1]
    n = L // CHUNK
    rs = lambda t: t.reshape(B, H, n, CHUNK, *t.shape[3:])
    q, k, v, beta, g = rs(q), rs(k), rs(v), rs(beta), rs(g)
    G = jnp.cumsum(g, axis=-1)
    causal = jnp.tril(jnp.ones((CHUNK, CHUNK), dtype=bool))
    strict = jnp.tril(jnp.ones((CHUNK, CHUNK), dtype=bool), -1)
    decay = jnp.exp(jnp.where(causal, G[..., :, None] - G[..., None, :], -jnp.inf))
    kk = jnp.einsum('bhncd,bhned->bhnce', k, k)
    A = jnp.where(strict, beta[..., :, None] * kk * decay, 0.0)
    eye = jnp.eye(CHUNK, dtype=jnp.float32)
    T = lax.linalg.triangular_solve(eye + A, jnp.broadcast_to(eye, A.shape),
                                    left_side=True, lower=True)
    eG = jnp.exp(G)
    W = jnp.einsum('bhnce,bhned->bhncd', T, k * (beta * eG)[..., None])
    U = jnp.einsum('bhnce,bhned->bhncd', T, v * beta[..., None])
    qk = jnp.einsum('bhncd,bhned->bhnce', q, k) * decay
    qg = q * eG[..., None]
    kd = k * jnp.exp(G[..., -1:] - G)[..., None]
    glast = jnp.exp(G[..., -1])

    def step(S, inp):
        Wc, Uc, qkc, qgc, kdc, gc = inp
        v_new = Uc - jnp.einsum('bhcd,bhdv->bhcv', Wc, S)
        o = jnp.einsum('bhcd,bhdv->bhcv', qgc, S) + jnp.einsum('bhce,bhev->bhcv', qkc, v_new)
        S = S * gc[..., None, None] + jnp.einsum('bhcd,bhcv->bhdv', kdc, v_new)
        return S, o

    xs = tuple(jnp.moveaxis(t, 2, 0) for t in (W, U, qk, qg, kd, glast))
    S0 = jnp.zeros((B, H, dk, dv), jnp.float32)
    _, o = lax.scan(step, S0, xs)
    return jnp.moveaxis(o, 0, 2).reshape(B, H, L, dv)


def trailing_mean(u, w):
    L = u.shape[1]
    cs = jnp.cumsum(u.astype(jnp.float32), axis=1)
    cs = jnp.pad(cs, ((0, 0), (w, 0), (0, 0)))
    window_sum = cs[:, w:] - cs[:, :L]
    count = jnp.minimum(jnp.arange(L) + 1, w).astype(jnp.float32)
    return (window_sum / count[None, :, None]).astype(u.dtype)


def multiscale_pool(u, pool_w, pool_scale):
    B, L, _ = u.shape
    ug = u.reshape(B, L, POOL_GROUPS, POOL_GROUP_DIM)
    pooled = jnp.stack([trailing_mean(ug[:, :, i], POOL_WINDOWS[i]) for i in range(POOL_GROUPS)],
                       axis=2) - ug
    y = jnp.einsum('blgc,gcd->blgd', pooled, pool_w)
    return y.reshape(B, L, POOL_WIDTH) * pool_scale


def moe_ffn(h, w_router, b_router, w_gate_up, b_gate_up, w_down, b_down):
    B, L, D = h.shape
    t = h.reshape(B * L, D)
    logits = (t @ w_router + b_router).astype(jnp.float32)
    top_v, top_i = lax.top_k(logits, TOP_K)
    top_w = jax.nn.softmax(top_v, axis=-1)
    comb = jnp.sum(jax.nn.one_hot(top_i, N_EXPERTS, dtype=jnp.float32) * top_w[..., None],
                   axis=1).astype(h.dtype)
    y = jnp.zeros_like(t)
    for e in range(N_EXPERTS):
        gu = t @ w_gate_up[e] + b_gate_up[e]
        gate, up = gu[:, :D_FF], gu[:, D_FF:]
        gate = jnp.minimum(gate, SWIGLU_LIMIT)
        up = jnp.clip(up, -SWIGLU_LIMIT, SWIGLU_LIMIT)
        act = gate * jax.nn.sigmoid(SWIGLU_ALPHA * gate) * (up + 1.0)
        y = y + comb[:, e:e + 1] * (act @ w_down[e] + b_down[e])
    return y.reshape(B, L, D)


def setup_inputs(seed: int = 0) -> dict:
    key = jax.random.key(seed)
    ks = jax.random.split(key, 24)
    f32 = jnp.float32
    nrm = lambda k, shape, s: jax.random.normal(k, shape, f32) * s
    dt = jnp.exp(jax.random.uniform(ks[4], (DEPTH, DN_HEADS), f32,
                                    math.log(1e-3), math.log(1e-1)))
    return {
        "x": jax.random.normal(ks[0], (BATCH, SEQ, D_MODEL), f32),
        "g_mix": 1.0 + nrm(ks[1], (DEPTH, D_MODEL), 0.02),
        "w_in": nrm(ks[2], (DEPTH, D_MODEL, IN_WIDTH), D_MODEL ** -0.5),
        "conv_w": nrm(ks[3], (DEPTH, CONV_WIDTH, 3 * DN_WIDTH), CONV_WIDTH ** -0.5),
        "a_log": jnp.log(jax.random.uniform(ks[5], (DEPTH, DN_HEADS), f32, 1.0, 16.0)),
        "dt_bias": dt + jnp.log(-jnp.expm1(-dt)),
        "dn_norm": 1.0 + nrm(ks[6], (DEPTH, DN_HEAD_DIM), 0.02),
        "w_up_a": nrm(ks[7], (DEPTH, DN_WIDTH, D_MODEL), DN_WIDTH ** -0.5),
        "pool_w": nrm(ks[8], (DEPTH, POOL_GROUPS, POOL_GROUP_DIM, POOL_GROUP_DIM), POOL_GROUP_DIM ** -0.5),
        "pool_scale": 1.0 + nrm(ks[9], (DEPTH, POOL_WIDTH), 0.02),
        "w_up_b": nrm(ks[10], (DEPTH, POOL_WIDTH, D_MODEL), POOL_WIDTH ** -0.5),
        "w_out": nrm(ks[11], (DEPTH, D_MODEL, D_MODEL), D_MODEL ** -0.5),
        "g_ffn": 1.0 + nrm(ks[12], (DEPTH, D_MODEL), 0.02),
        "w_router": nrm(ks[13], (DEPTH, D_MODEL, N_EXPERTS), D_MODEL ** -0.5),
        "b_router": nrm(ks[14], (DEPTH, N_EXPERTS), 0.01),
        "w_gate_up": nrm(ks[15], (DEPTH, N_EXPERTS, D_MODEL, 2 * D_FF), D_MODEL ** -0.5),
        "b_gate_up": nrm(ks[16], (DEPTH, N_EXPERTS, 2 * D_FF), 0.01),
        "w_down": nrm(ks[17], (DEPTH, N_EXPERTS, D_FF, D_MODEL), D_FF ** -0.5),
        "b_down": nrm(ks[18], (DEPTH, N_EXPERTS, D_MODEL), 0.01),
        "g_final": 1.0 + nrm(ks[19], (D_MODEL,), 0.02),
    }


def reference(x, g_mix, w_in, conv_w, a_log, dt_bias, dn_norm, w_up_a, pool_w, pool_scale,
              w_up_b, w_out, g_ffn, w_router, b_router, w_gate_up, b_gate_up, w_down, b_down,
              g_final):
    f32 = jnp.float32
    B, L, D = x.shape
    sizes = [3 * DN_WIDTH, DN_WIDTH, DN_HEADS, DN_HEADS, POOL_WIDTH]
    split_idx = [int(s) for s in np.cumsum(sizes)]
    for l in range(DEPTH):
        h = rms_norm(x, g_mix[l])
        p = h @ w_in[l]
        qkv, z, b_raw, a_raw, u, gates = jnp.split(p, split_idx, axis=-1)

        qkv = jax.nn.silu(causal_depthwise_conv(qkv, conv_w[l]))
        q, k, v = jnp.split(qkv, 3, axis=-1)
        heads = lambda t: t.reshape(B, L, DN_HEADS, DN_HEAD_DIM).transpose(0, 2, 1, 3).astype(f32)
        q = l2_normalize(heads(q)) * (DN_HEAD_DIM ** -0.5)
        k = l2_normalize(heads(k))
        v = heads(v)
        beta = jax.nn.sigmoid(b_raw.astype(f32)).transpose(0, 2, 1)
        g = (-jnp.exp(a_log[l].astype(f32))
             * jax.nn.softplus(a_raw.astype(f32) + dt_bias[l].astype(f32))).transpose(0, 2, 1)
        o = chunked_gated_delta_rule(q, k, v, beta, g).transpose(0, 2, 1, 3)
        o = rms_norm(o, dn_norm[l]) * jax.nn.silu(z.reshape(B, L, DN_HEADS, DN_HEAD_DIM).astype(f32))
        y_a = o.reshape(B, L, DN_WIDTH).astype(x.dtype) @ w_up_a[l]

        y_b = multiscale_pool(u, pool_w[l], pool_scale[l]) @ w_up_b[l]

        gate_a, gate_b = jnp.split(jax.nn.sigmoid(gates), N_BRANCH, axis=-1)
        x = x + (gate_a * y_a + gate_b * y_b) @ w_out[l]

        x = x + moe_ffn(rms_norm(x, g_ffn[l]), w_router[l], b_router[l], w_gate_up[l],
                        b_gate_up[l], w_down[l], b_down[l])
    return rms_norm(x, g_final)
```

```cpp
#include <hip/hip_runtime.h>
#include <stdint.h>
#include <stdio.h>

#ifndef N_LAUNCHES
#define N_LAUNCHES 1
#endif

#define LAS __attribute__((address_space(3)))
typedef unsigned short bf16_t;
typedef short bf16x8 __attribute__((ext_vector_type(8)));
typedef float f32x4 __attribute__((ext_vector_type(4)));
typedef float f32x2 __attribute__((ext_vector_type(2)));
typedef unsigned u32x4 __attribute__((ext_vector_type(4)));
typedef unsigned u32x2 __attribute__((ext_vector_type(2)));
typedef __bf16 bfx2 __attribute__((ext_vector_type(2)));
#define DI __device__ __forceinline__

constexpr int T_ = 32768, D_ = 1024, L_ = 4096, NH = 8, NCH = 64;
constexpr int NP = 4608;
constexpr int PC_Q = 0, PC_K = 512, PC_V = 1024, PC_Z = 1536, PC_U = 2048, PC_GA = 2560, PC_GB = 3584;
constexpr int INW = 4624;
constexpr int NE = 32, LISTCAP = 32768;
constexpr int ACT_ROWS = 131072 + 8192;
constexpr float EPS = 1e-6f;
constexpr int NPHASE = 11;

constexpr size_t al256(size_t x) { return (x + 255) & ~(size_t)255; }
constexpr size_t WS_CTL = 0;
constexpr size_t CTL_BYTES = 65536;
constexpr size_t CW_BAR = 0;
constexpr size_t CW_CNT = 16384;
constexpr size_t WS_WIN = WS_CTL + CTL_BYTES;
constexpr size_t WS_WA = WS_WIN + (size_t)NP * 1024 * 2;
constexpr size_t WS_WB = WS_WA + (size_t)1024 * 512 * 2;
constexpr size_t WS_WOUT = WS_WB + (size_t)1024 * 512 * 2;
constexpr size_t WS_WGU = WS_WOUT + (size_t)1024 * 1024 * 2;
constexpr size_t WS_WD = WS_WGU + (size_t)NE * 2048 * 1024 * 2;
constexpr size_t WS_H = WS_WD + (size_t)NE * 1024 * 1024 * 2;
constexpr size_t WS_P = WS_H + (size_t)T_ * 1024 * 2;
constexpr size_t WS_DELTA = WS_P + (size_t)T_ * NP * 2;
DI int dl_cmajor(int unit) { return (unit & 63) * 64 + (unit >> 6); }
constexpr size_t DL_M = 0, DL_Q = (size_t)4096 * 8192, DL_S = 2 * DL_Q, DL_N = 3 * DL_Q, DL_O = DL_N + (size_t)4096 * 16384;
constexpr size_t WS_PM = WS_DELTA + (size_t)T_ * 4 * 1024 * 2;
constexpr size_t WS_OA = WS_PM + (size_t)T_ * 512 * 2;
constexpr size_t WS_TOPW = WS_OA + (size_t)T_ * 512 * 2;
constexpr size_t WS_LIST = WS_TOPW + (size_t)T_ * 4 * 4;
constexpr size_t WS_PARK = WS_LIST + (size_t)NE * LISTCAP * 4;
constexpr size_t WS_BA = WS_PARK + (size_t)2048 * 8192;
constexpr size_t WS_END = WS_BA + (size_t)T_ * 16 * 4;
static_assert(WS_END <= (size_t)1073741824, "workspace");
static_assert((size_t)ACT_ROWS * 1024 <= (size_t)T_ * NP * 2, "act (fp8) fits in p");

constexpr int LDS_BYTES = 163840;
constexpr int LDS_BARW = LDS_BYTES - 16;

DI unsigned pk_bf16(float lo, float hi) { bfx2 r = __builtin_convertvector((f32x2){lo, hi}, bfx2); return __builtin_bit_cast(unsigned, r); }
typedef int i32x8 __attribute__((ext_vector_type(8)));
typedef int i32x4 __attribute__((ext_vector_type(4)));
DI float clamp448(float x) { return fminf(fmaxf(x, -448.f), 448.f); }
DI unsigned pk4_fp8(float a, float b, float c, float d) {
    int w = 0; w = __builtin_amdgcn_cvt_pk_fp8_f32(clamp448(a), clamp448(b), w, false); w = __builtin_amdgcn_cvt_pk_fp8_f32(clamp448(c), clamp448(d), w, true); return (unsigned)w; }
constexpr float SC_H2 = 16.f, SC_ACT = 4.f, SC_W = 64.f, SC_Y = 16.f;
constexpr int E8_H2 = 0x7B7B7B7B, E8_ACT = 0x7D7D7D7D, E8_W = 0x79797979;
DI float bflo(unsigned u) { return __uint_as_float(u << 16); }
DI float bfhi(unsigned u) { return __uint_as_float(u & 0xffff0000u); }
DI float bf2f(unsigned short b) { return __uint_as_float(((unsigned)b) << 16); }
DI float fast_rcp(float x) { return __builtin_amdgcn_rcpf(x); }
DI float sigmoidf_(float x) { return fast_rcp(1.f + __expf(-x)); }
DI float siluf_(float x) { return x * sigmoidf_(x); }
DI float bperm(float v, int src_lane) { return __int_as_float(__builtin_amdgcn_ds_bpermute(src_lane << 2, __float_as_int(v))); }
DI void wsync() { asm volatile("s_waitcnt lgkmcnt(0)" ::: "memory"); }
DI float wave_sum(float v) {
#pragma unroll
    for (int m = 32; m >= 1; m >>= 1) v += __shfl_xor(v, m);
    return v;
}
DI bf16x8 mk8(u32x2 lo, u32x2 hi) { u32x4 v = {lo.x, lo.y, hi.x, hi.y}; return __builtin_bit_cast(bf16x8, v); }
DI bf16x8 pack2(f32x4 a, f32x4 b) { u32x4 v = {pk_bf16(a[0], a[1]), pk_bf16(a[2], a[3]), pk_bf16(b[0], b[1]), pk_bf16(b[2], b[3])}; return __builtin_bit_cast(bf16x8, v); }
DI f32x4 mfma16(bf16x8 a, bf16x8 b, f32x4 c) { return __builtin_amdgcn_mfma_f32_16x16x32_bf16(a, b, c, 0, 0, 0); }

#define XB_TMO      128
#define XB_XCNT(j)  (256  + 64 * (j))
#define XB_XSUB(j)  (1280 + 64 * (j))
#define XB_XGEN(j)  (2304 + 64 * (j))
#define XB_TOP      3328
#define XB_TOPGEN   3392
#define XCD_BAR_WORDS 3456
#define XB_SPIN_CAP (1u << 18)
DI unsigned xb_ld(unsigned* p)              { return __hip_atomic_load(p, __ATOMIC_RELAXED, __HIP_MEMORY_SCOPE_AGENT); }
DI unsigned xb_add(unsigned* p, unsigned v) { return __hip_atomic_fetch_add(p, v, __ATOMIC_RELAXED, __HIP_MEMORY_SCOPE_AGENT); }
DI unsigned xb_xcc_id() { return (unsigned)__builtin_amdgcn_s_getreg((3 << 11) | 20) & 0xFu; }
#define XB_SPIN(cond, bar) do { unsigned _sp = 0; while (cond) { __builtin_amdgcn_s_sleep(1); \
    if ((++_sp & 255u) == 0u) { if (xb_ld(&(bar)[XB_TMO])) break; if (_sp > XB_SPIN_CAP) { atomicAdd(&(bar)[XB_TMO], 1u); break; } } } } while (0)
struct XcdBarrier { unsigned* bar; unsigned x; volatile LAS unsigned* st; };
DI XcdBarrier xcd_barrier_post(unsigned* bar, volatile LAS unsigned* st, bool t0) {
    XcdBarrier b; b.bar = bar; b.x = xb_xcc_id(); b.st = st;
    if (t0) (void)xb_add(&bar[XB_XCNT(b.x)], 1u);
    return b;
}
DI void xcd_barrier_complete(unsigned* bar, unsigned x, unsigned& nloc, unsigned& nx) {
    const unsigned G = gridDim.x * gridDim.y * gridDim.z;
    unsigned sum, cnt, mine, sp = 0u;
    for (;;) {
        sum = 0u; cnt = 0u; mine = 0u;
#pragma unroll
        for (unsigned j = 0; j < 16; ++j) { const unsigned c = xb_ld(&bar[XB_XCNT(j)]); sum += c; cnt += (c > 0u) ? 1u : 0u; mine = (j == x) ? c : mine; }
        if (sum == G) break;
        __builtin_amdgcn_s_sleep(1);
        if ((++sp & 255u) == 0u) { if (xb_ld(&bar[XB_TMO])) break; if (sp > XB_SPIN_CAP) { atomicAdd(&bar[XB_TMO], 1u); break; } }
    }
    nloc = mine > 0u ? mine : 1u; nx = cnt > 0u ? cnt : 1u;
}
DI void xcd_barrier(const XcdBarrier& b, bool t0) {
    asm volatile("s_waitcnt vmcnt(0)" ::: "memory");
    __syncthreads();
    if (t0) {
        unsigned* bar = b.bar;
        __builtin_amdgcn_s_waitcnt(0);
        unsigned nloc = b.st[0], nx = b.st[1];
        if (nloc == 0u) { xcd_barrier_complete(bar, b.x, nloc, nx); b.st[0] = nloc; b.st[1] = nx; }
        const unsigned old = xb_add(&bar[XB_XSUB(b.x)], 1u);
        const unsigned gen = old / nloc;
        if (old + 1u == (gen + 1u) * nloc) {
            __builtin_amdgcn_fence(__ATOMIC_RELEASE, "agent");
            asm volatile("s_waitcnt vmcnt(0)" ::: "memory");
            const unsigned og = xb_add(&bar[XB_TOP], 1u);
            const unsigned tg = og / nx;
            if (og + 1u == (tg + 1u) * nx) xb_add(&bar[XB_TOPGEN], 1u);
            else XB_SPIN(xb_ld(&bar[XB_TOPGEN]) == tg, bar);
            __builtin_amdgcn_fence(__ATOMIC_ACQUIRE, "agent");
            xb_add(&bar[XB_XGEN(b.x)], 1u);
            asm volatile("s_waitcnt vmcnt(0)" ::: "memory");
        } else {
            XB_SPIN(xb_ld(&bar[XB_XGEN(b.x)]) == gen, bar);
            __builtin_amdgcn_fence(__ATOMIC_ACQUIRE, "agent");
            asm volatile("s_waitcnt vmcnt(0)" ::: "memory");
        }
    }
    __syncthreads();
}

namespace pg8 {
constexpr int BM = 256, BK = 64, HALF = 128, HTB = HALF * BK * 2, STAGE_BYTES = 8 * HTB, NXCD = 8, WGM = 8;
__host__ __device__ __forceinline__ int lds_byte(int r, int c) { const int st = (r >> 4) * 2 + (c >> 5), rr = r & 15, cc = c & 31, ob = rr * 64 + cc * 2; return st * 1024 + (ob ^ (((ob >> 9) & 1) << 5)); }
__host__ __device__ __forceinline__ void stage_rc(int b, int& R, int& C) { const int st = b / 1024, sb = b % 1024, swz = sb ^ (((sb >> 9) & 1) << 5); R = (st >> 1) * 16 + swz / 64; C = (st & 1) * 32 + (swz % 64) / 2; }
__host__ __device__ __forceinline__ int perm32(int rho) { const int n = rho >> 4, i = rho & 15; return 8 * (i >> 2) + 4 * n + (i & 3); }

struct Unit { int pm, pn, e; };

struct StaticOrder {
    int nM, nN, nwg, G, c;
    DI void init(int M, int N, int G_, int c_) { nM = M / BM; nN = N / BM; nwg = nM * nN; G = G_; c = c_; }
    DI bool next(int i, Unit& u) const {
        const long L = (long)i * G + c; if (L >= nwg) return false;
        int wgid = (int)L; { const int q = nwg / NXCD, r = nwg % NXCD, xcd = wgid % NXCD, off = wgid / NXCD; wgid = (xcd < r ? xcd * (q + 1) : r * (q + 1) + (xcd - r) * q) + off; }
        const int nig = WGM * nN, gid = wgid / nig, fm = gid * WGM, gsz = (nM - fm) < WGM ? (nM - fm) : WGM;
        u.pm = fm + ((wgid % nig) % gsz); u.pn = (wgid % nig) / gsz; u.e = 0; return true;
    }
};

template <bool FP8> struct FragT { typedef bf16x8 type; };
template <> struct FragT<true> { typedef i32x8 type; };
template <class Epi, class Sched, bool FP8 = false>
DI void gemm_phase(LAS unsigned char* lds, const int tid, const int K, const Sched& S, const Epi& E, const int sclW = 0, const int sclA = 0) {
    const int wid = __builtin_amdgcn_readfirstlane(tid >> 6), lane = tid & 63, wr = wid >> 2, wc = wid & 3, fr = lane & 15, fq = lane >> 4;
    const int nt = K / BK;
    int R0, C0; stage_rc(tid * 16, R0, C0);
    const int Rb0 = Epi::PERM ? ((R0 & ~31) + perm32(R0 & 31)) : R0;
    unsigned voffB[2]; voffB[0] = (unsigned)(Rb0 * K + C0) * 2u; voffB[1] = (unsigned)((Rb0 + 64) * K + C0) * 2u;
    const size_t kstep = (size_t)(BK * 2);
    const size_t hstep = (size_t)HALF * K * 2;
    const unsigned ldsw = (unsigned)wid * 1024u;
    const int aoff = lds_byte(wr * 64 + fr, fq * 8), boff = lds_byte(wc * 32 + fr, fq * 8);
#define PG8_SA(b, h) (((b) * 2 + (h)) * HTB)
#define PG8_SB(b, h) ((4 + (b) * 2 + (h)) * HTB)
#define PG8_STAGE(bufoff, gbase, voff) do { _Pragma("unroll") for (int _i = 0; _i < 2; ++_i) \
        __builtin_amdgcn_global_load_lds((const unsigned*)((const char*)(gbase) + (voff)[_i]), (LAS unsigned*)(lds + (bufoff) + ldsw + _i * 8192), 16, 0, 0); } while (0)
#define PG8_LD2(p) __builtin_shufflevector(*(const LAS i32x4*)(p), *(const LAS i32x4*)((p) + 1024), 0, 1, 2, 3, 4, 5, 6, 7)
#define PG8_LDA(dst, b, h) do { _Pragma("unroll") for (int m = 0; m < 4; ++m) { if constexpr (FP8) dst[m][0] = __builtin_bit_cast(frag_t, PG8_LD2(lds + PG8_SA(b, h) + aoff + m * 2048)); \
        else { _Pragma("unroll") for (int k = 0; k < 2; ++k) dst[m][k] = __builtin_bit_cast(frag_t, *(const LAS bf16x8*)(lds + PG8_SA(b, h) + aoff + m * 2048 + k * 1024)); } } } while (0)
#define PG8_LDB(dst, b, h) do { _Pragma("unroll") for (int n = 0; n < 2; ++n) { if constexpr (FP8) dst[n][0] = __builtin_bit_cast(frag_t, PG8_LD2(lds + PG8_SB(b, h) + boff + n * 2048)); \
        else { _Pragma("unroll") for (int k = 0; k < 2; ++k) dst[n][k] = __builtin_bit_cast(frag_t, *(const LAS bf16x8*)(lds + PG8_SB(b, h) + boff + n * 2048 + k * 1024)); } } } while (0)
#define PG8_MMA(ai, bj, At, Bt) do { __builtin_amdgcn_s_setprio(1); _Pragma("unroll") for (int m = 0; m < 4; ++m) _Pragma("unroll") for (int n = 0; n < 2; ++n) { \
        if constexpr (FP8) asm volatile("v_mfma_scale_f32_16x16x128_f8f6f4 %0, %1, %2, %0, %3, %4 op_sel_hi:[0,0,0]" : "+v"(acc[ai][bj][m][n]) : "v"(Bt[n][0]), "v"(At[m][0]), "v"(sclW), "v"(sclA)); \
        else { _Pragma("unroll") for (int k = 0; k < 2; ++k) acc[ai][bj][m][n] = __builtin_amdgcn_mfma_f32_16x16x32_bf16(__builtin_bit_cast(bf16x8, Bt[n][k]), __builtin_bit_cast(bf16x8, At[m][k]), acc[ai][bj][m][n], 0, 0, 0); } } \
        __builtin_amdgcn_s_setprio(0); } while (0)
#define PG8_WAIT_V(n) asm volatile("s_waitcnt vmcnt(" #n ")" ::: "memory")
#define PG8_WAIT_L(n) asm volatile("s_waitcnt lgkmcnt(" #n ")" ::: "memory")
#define PG8_BAR __builtin_amdgcn_s_barrier()
#define PG8_SCHED __builtin_amdgcn_sched_barrier(0)
    Unit cur, nxt; int ui = 0;
    if (!S.next(0, cur)) return;
    f32x4 acc[2][2][4][2];
#pragma unroll
    for (int a = 0; a < 2; ++a)
#pragma unroll
        for (int b = 0; b < 2; ++b)
#pragma unroll
            for (int m = 0; m < 4; ++m)
#pragma unroll
                for (int n = 0; n < 2; ++n) acc[a][b][m][n] = (f32x4){0.f, 0.f, 0.f, 0.f};
    typedef typename FragT<FP8>::type frag_t;
    frag_t At[4][FP8 ? 1 : 2], B0[2][FP8 ? 1 : 2], B1[2][FP8 ? 1 : 2];
    unsigned ca[2][2], na[2][2];
    S.a_offs(cur, R0, C0, ca);
    const char* cA = S.a_base(cur); const char* cB = S.b_tile(cur);
    PG8_STAGE(PG8_SB(0, 0), cB, voffB); PG8_STAGE(PG8_SB(0, 1), cB + hstep, voffB); PG8_STAGE(PG8_SA(0, 0), cA, ca[0]); PG8_STAGE(PG8_SA(0, 1), cA, ca[1]);
    if (wr == 1) PG8_BAR;
    PG8_WAIT_V(2); PG8_BAR;
    PG8_STAGE(PG8_SB(1, 0), cB + kstep, voffB); PG8_STAGE(PG8_SA(1, 0), cA + kstep, ca[0]); PG8_STAGE(PG8_SB(1, 1), cB + hstep + kstep, voffB);
    PG8_WAIT_V(6); PG8_BAR;
    for (;;) {
        const bool has_next = S.next(ui + 1, nxt);
        const char* nA = cA; const char* nB = cB;
#pragma unroll
        for (int h = 0; h < 2; ++h) { na[h][0] = ca[h][0]; na[h][1] = ca[h][1]; }
        if (has_next) { nA = S.a_base(nxt); nB = S.b_tile(nxt); S.a_offs(nxt, R0, C0, na); }
        for (int t = 0; t < nt; t += 2) {
            const bool last = (t == nt - 2);
            const char* a1 = cA + (size_t)(t + 1) * kstep;
            const char* a2 = last ? nA : cA + (size_t)(t + 2) * kstep; const char* b2 = last ? nB : cB + (size_t)(t + 2) * kstep;
            const char* a3 = a2 + kstep; const char* b3 = b2 + kstep;
            unsigned sa[2][2];
            if (last) {
#pragma unroll
                for (int h = 0; h < 2; ++h) { sa[h][0] = na[h][0]; sa[h][1] = na[h][1]; }
            } else {
#pragma unroll
                for (int h = 0; h < 2; ++h) { sa[h][0] = ca[h][0]; sa[h][1] = ca[h][1]; }
            }
            PG8_LDB(B0, 0, 0); PG8_LDB(B1, 0, 1); PG8_SCHED; PG8_LDA(At, 0, 0); PG8_STAGE(PG8_SA(1, 1), a1, ca[1]);
            PG8_WAIT_V(8); PG8_WAIT_L(0); PG8_BAR; PG8_MMA(0, 0, At, B0); PG8_MMA(0, 1, At, B1); PG8_BAR; PG8_SCHED;
            PG8_LDA(At, 0, 1); PG8_STAGE(PG8_SB(0, 0), b2, voffB); PG8_STAGE(PG8_SB(0, 1), b2 + hstep, voffB); PG8_STAGE(PG8_SA(0, 0), a2, sa[0]);
            PG8_WAIT_V(8); PG8_WAIT_L(0); PG8_BAR; PG8_MMA(1, 0, At, B0); PG8_MMA(1, 1, At, B1); PG8_BAR; PG8_SCHED;
            PG8_LDB(B0, 1, 0); PG8_LDB(B1, 1, 1); PG8_SCHED; PG8_LDA(At, 1, 0); PG8_STAGE(PG8_SA(0, 1), a2, sa[1]);
            PG8_WAIT_V(8); PG8_WAIT_L(0); PG8_BAR; PG8_MMA(0, 0, At, B0); PG8_MMA(0, 1, At, B1); PG8_BAR; PG8_SCHED;
            PG8_LDA(At, 1, 1); PG8_STAGE(PG8_SB(1, 0), b3, voffB); PG8_STAGE(PG8_SB(1, 1), b3 + hstep, voffB); PG8_STAGE(PG8_SA(1, 0), a3, sa[0]);
            PG8_WAIT_V(8); PG8_WAIT_L(0); PG8_BAR; PG8_MMA(1, 0, At, B0); PG8_MMA(1, 1, At, B1); PG8_BAR; PG8_SCHED;
        }
        if constexpr (FP8) asm volatile("s_nop 15\n\ts_nop 15" ::: "memory");
        if (wr == 0) PG8_BAR;
        const bool keep = E(acc, cur, wr, wc, fr, fq);
        if (!has_next) break;
        if (!keep) {
#pragma unroll
            for (int a = 0; a < 2; ++a)
#pragma unroll
                for (int b = 0; b < 2; ++b)
#pragma unroll
                    for (int m = 0; m < 4; ++m)
#pragma unroll
                        for (int n = 0; n < 2; ++n) acc[a][b][m][n] = (f32x4){0.f, 0.f, 0.f, 0.f};
        }
        cur = nxt; cA = nA; cB = nB; ++ui;
#pragma unroll
        for (int h = 0; h < 2; ++h) { ca[h][0] = na[h][0]; ca[h][1] = na[h][1]; }
        if (wr == 1) PG8_BAR;
    }
    PG8_WAIT_V(0);
    PG8_BAR;
#undef PG8_SA
#undef PG8_SB
#undef PG8_STAGE
#undef PG8_LDA
#undef PG8_LDB
#undef PG8_MMA
#undef PG8_LD2
#undef PG8_WAIT_V
#undef PG8_WAIT_L
#undef PG8_BAR
#undef PG8_SCHED
}
}
using pg8::Unit;

struct Params { const float* in[20]; float* out; unsigned char* ws; int ph_lo, ph_hi; };
enum { I_X = 0, I_GMIX, I_WIN, I_CONVW, I_ALOG, I_DTB, I_DNN, I_WUPA, I_POOLW, I_POOLS, I_WUPB, I_WOUT, I_GFFN, I_WR, I_BR, I_WGU, I_BGU, I_WD, I_BD, I_GFIN };

struct Frame {
    LAS unsigned char* lds; int tid, lane, wid, G, bid;
    const float* in[20]; float* out; unsigned char* ws;
};

struct DenseSched {
    const char* A; const char* Bt; int K; pg8::StaticOrder so; int mixgate;
    DI bool next(int i, Unit& u) const { const bool ok = so.next(i, u); if (mixgate) { const int s = u.pn; u.pn = s >= 16 ? s - 8 : ((s & 1) ? 10 + (s >> 1) : (s >> 1)); } return ok; }
    DI const char* a_base(const Unit&) const { return A; }
    DI const char* b_tile(const Unit& u) const { return Bt + (size_t)u.pn * 256 * K * 2; }
    DI void a_offs(const Unit& u, int R0, int C0, unsigned (&o)[2][2]) const {
#pragma unroll
        for (int h = 0; h < 2; ++h)
#pragma unroll
            for (int i = 0; i < 2; ++i) o[h][i] = (unsigned)((u.pm * 256 + h * 128 + R0 + 64 * i) * K + C0) * 2u;
    }
};
struct UpSched {
    const char* A0; const char* A1; const char* B0; const char* B1; pg8::StaticOrder so;
    DI bool next(int i, Unit& u) const { const bool ok = so.next(i >> 1, u); u.e = i & 1; return ok; }
    DI const char* a_base(const Unit& u) const { return u.e ? A1 : A0; }
    DI const char* b_tile(const Unit& u) const { return (u.e ? B1 : B0) + (size_t)u.pn * 256 * 512 * 2; }
    DI void a_offs(const Unit& u, int R0, int C0, unsigned (&o)[2][2]) const {
#pragma unroll
        for (int h = 0; h < 2; ++h)
#pragma unroll
            for (int i = 0; i < 2; ++i) o[h][i] = (unsigned)((u.pm * 256 + h * 128 + R0 + 64 * i) * 512 + C0) * 2u;
    }
};
struct MoeTbl { int rts[NE + 1]; int cnt[NE]; };
struct MoeSched {
    const char* A; const char* Bt; const int* list; const LAS MoeTbl* tb; int K, NT  , RG  , bid; size_t bstride; bool gather;
    DI bool next(int i, Unit& u) const {
        const int xcd = bid & 7, j = bid >> 3;
        const int rt = RG * (i * 8 + xcd) + j / NT;
        if (rt >= tb->rts[NE]) return false;
        int e = 0;
        for (int q = 1; q < NE; ++q) e += (tb->rts[q] <= rt) ? 1 : 0;
        u.pm = rt; u.pn = j % NT; u.e = e; return true;
    }
    DI const char* a_base(const Unit&) const { return A; }
    DI const char* b_tile(const Unit& u) const { return Bt + (size_t)u.e * bstride + (size_t)u.pn * 256 * K * 2; }
    DI void a_offs(const Unit& u, int R0, int C0, unsigned (&o)[2][2]) const {
        const int lr0 = (u.pm - tb->rts[u.e]) * 256, cnt = tb->cnt[u.e];
#pragma unroll
        for (int h = 0; h < 2; ++h)
#pragma unroll
            for (int i = 0; i < 2; ++i) {
                const int r = h * 128 + R0 + 64 * i;
                int row;
                if (gather) { const int idx = lr0 + r; row = list[u.e * LISTCAP + (idx < cnt ? idx : cnt - 1)] >> 2; }
                else row = u.pm * 256 + r;
                o[h][i] = (unsigned)(row * K + C0) * 2u;
            }
    }
};

template <int K> DI float ubf(unsigned w) { float r; if (K == 0) asm("v_cvt_f32_ubyte0 %0, %1" : "=v"(r) : "v"(w)); else if (K == 1) asm("v_cvt_f32_ubyte1 %0, %1" : "=v"(r) : "v"(w)); else if (K == 2) asm("v_cvt_f32_ubyte2 %0, %1" : "=v"(r) : "v"(w)); else asm("v_cvt_f32_ubyte3 %0, %1" : "=v"(r) : "v"(w)); return r; }
struct EpiStoreBf16 {
    static constexpr bool PERM = true;
    bf16_t* O; int ldc;
    DI bool operator()(f32x4 (&acc)[2][2][4][2], const Unit& u, int wr, int wc, int fr, int fq) const {
        const int row0 = u.pm * 256 + wr * 64 + fr, col0 = u.pn * 256 + wc * 32 + 8 * fq;
#pragma unroll
        for (int ai = 0; ai < 2; ++ai)
#pragma unroll
            for (int m = 0; m < 4; ++m) { bf16_t* rowp = O + (size_t)(row0 + ai * 128 + m * 16) * ldc + col0;
#pragma unroll
                for (int bj = 0; bj < 2; ++bj) { const f32x4 v0 = acc[ai][bj][m][0], v1 = acc[ai][bj][m][1];
                    u32x4 w; w.x = pk_bf16(v0[0], v0[1]); w.y = pk_bf16(v0[2], v0[3]); w.z = pk_bf16(v1[0], v1[1]); w.w = pk_bf16(v1[2], v1[3]);
                    *(u32x4*)(rowp + bj * 128) = w; } }
        return false;
    }
};
struct EpiP {
    static constexpr bool PERM = true;
    bf16_t* O;
    DI bool operator()(f32x4 (&acc)[2][2][4][2], const Unit& u, int wr, int wc, int fr, int fq) const {
        const int row0 = u.pm * 256 + wr * 64 + fr;
        const bool gate = u.pn >= 10;
        const int colA = gate ? PC_GA + (u.pn - 10) * 128 + wc * 32 + 8 * fq : u.pn * 256 + wc * 32 + 8 * fq;
        const int colB = gate ? PC_GB + (u.pn - 10) * 128 + wc * 32 + 8 * fq : colA + 128;
#pragma unroll
        for (int ai = 0; ai < 2; ++ai)
#pragma unroll
            for (int m = 0; m < 4; ++m) { bf16_t* rowp = O + (size_t)(row0 + ai * 128 + m * 16) * NP;
                float a[8], b[8];
#pragma unroll
                for (int j = 0; j < 8; ++j) { a[j] = acc[ai][0][m][j >> 2][j & 3]; b[j] = acc[ai][1][m][j >> 2][j & 3]; }
                if (gate) {
                    u32x4 w = {0u, 0u, 0u, 0u};
#pragma unroll
                    for (int j = 0; j < 8; ++j) { const float sa = fast_rcp(1.f + __expf(-a[j])), sb = fast_rcp(1.f + __expf(-b[j]));
                        const float qa = __builtin_rintf(sa * 255.f), qb = fmaxf(__builtin_rintf(sb * 255.f), 1.f);
                        if (j < 4) { w.x = __builtin_amdgcn_cvt_pk_u8_f32(qa, j & 3, w.x); w.z = __builtin_amdgcn_cvt_pk_u8_f32(qb, j & 3, w.z); }
                        else { w.y = __builtin_amdgcn_cvt_pk_u8_f32(qa, j & 3, w.y); w.w = __builtin_amdgcn_cvt_pk_u8_f32(qb, j & 3, w.w); } }
                    __builtin_nontemporal_store(w, (u32x4*)((unsigned char*)rowp + PC_GA * 2 + (((u.pn - 10) * 16 + wc * 4 + fq) * 16)));
                    continue;
                }
                u32x4 w; w.x = pk_bf16(a[0], a[1]); w.y = pk_bf16(a[2], a[3]); w.z = pk_bf16(a[4], a[5]); w.w = pk_bf16(a[6], a[7]);
                __builtin_nontemporal_store(w, (u32x4*)(rowp + colA));
                w.x = pk_bf16(b[0], b[1]); w.y = pk_bf16(b[2], b[3]); w.z = pk_bf16(b[4], b[5]); w.w = pk_bf16(b[6], b[7]);
                __builtin_nontemporal_store(w, (u32x4*)(rowp + colB)); }
        return false;
    }
};
struct EpiUp {
    static constexpr bool PERM = true;
    const bf16_t* P; bf16_t* O;
    DI bool operator()(f32x4 (&acc)[2][2][4][2], const Unit& u, int wr, int wc, int fr, int fq) const {
        const int row0 = u.pm * 256 + wr * 64 + fr, col0 = u.pn * 256 + wc * 32 + 8 * fq;
        const unsigned char* G = (const unsigned char*)P + PC_GA * 2 + (u.pn * 32 + wc * 4 + fq) * 16;
        u32x4 gva[2][4][2];
#pragma unroll
        for (int ai = 0; ai < 2; ++ai)
#pragma unroll
            for (int m = 0; m < 4; ++m)
#pragma unroll
                for (int bj = 0; bj < 2; ++bj) gva[ai][m][bj] = *(const u32x4*)(G + (size_t)(row0 + ai * 128 + m * 16) * (NP * 2) + bj * 256);
        __builtin_amdgcn_sched_barrier(0);
#pragma unroll
        for (int ai = 0; ai < 2; ++ai) {
#pragma unroll
            for (int m = 0; m < 4; ++m) { const size_t row = (size_t)(row0 + ai * 128 + m * 16);
#pragma unroll
                for (int bj = 0; bj < 2; ++bj) {
                    const u32x4 g4 = gva[ai][m][bj];
                    const float qb8[8] = {ubf<0>(g4.z), ubf<1>(g4.z), ubf<2>(g4.z), ubf<3>(g4.z), ubf<0>(g4.w), ubf<1>(g4.w), ubf<2>(g4.w), ubf<3>(g4.w)};
                    if (u.e == 0) {
                        const float qa8[8] = {ubf<0>(g4.x), ubf<1>(g4.x), ubf<2>(g4.x), ubf<3>(g4.x), ubf<0>(g4.y), ubf<1>(g4.y), ubf<2>(g4.y), ubf<3>(g4.y)};
#pragma unroll
                        for (int j = 0; j < 8; ++j) acc[ai][bj][m][j >> 2][j & 3] *= qa8[j] * fast_rcp(qb8[j]);
                    } else {
                        float o[8];
#pragma unroll
                        for (int j = 0; j < 8; ++j) o[j] = acc[ai][bj][m][j >> 2][j & 3] * (qb8[j] * (1.f / 255.f));
                        u32x4 w; w.x = pk_bf16(o[0], o[1]); w.y = pk_bf16(o[2], o[3]); w.z = pk_bf16(o[4], o[5]); w.w = pk_bf16(o[6], o[7]);
                        *(u32x4*)(O + row * 1024 + col0 + bj * 128) = w;
                    } } }
        }
        return u.e == 0;
    }
};
struct EpiResid {
    static constexpr bool PERM = false;
    const float* X; float* O;
    DI bool operator()(f32x4 (&acc)[2][2][4][2], const Unit& u, int wr, int wc, int fr, int fq) const {
        const int row0 = u.pm * 256 + wr * 64 + fr, col0 = u.pn * 256 + wc * 32 + 4 * fq;
#pragma unroll
        for (int ai = 0; ai < 2; ++ai)
#pragma unroll
            for (int m = 0; m < 4; ++m) { const size_t ro = (size_t)(row0 + ai * 128 + m * 16) * 1024 + col0;
#pragma unroll
                for (int bj = 0; bj < 2; ++bj)
#pragma unroll
                    for (int n = 0; n < 2; ++n) { const f32x4 xv = *(const f32x4*)(X + ro + bj * 128 + n * 16); *(f32x4*)(O + ro + bj * 128 + n * 16) = acc[ai][bj][m][n] + xv; } }
        return false;
    }
};
struct EpiGateUp {
    static constexpr bool PERM = true;
    unsigned char* ACT; const float* bgu;
    DI bool operator()(f32x4 (&acc)[2][2][4][2], const Unit& u, int wr, int wc, int fr, int fq) const {
        const int row0 = u.pm * 256 + wr * 64 + fr, c0 = u.pn * 128 + wc * 32 + 8 * fq;
        const float* bg = bgu + (size_t)u.e * 2048 + c0;
        f32x2 bgv[4], buv[4];
#pragma unroll
        for (int q = 0; q < 4; ++q) { bgv[q] = *(const f32x2*)(bg + 2 * q); buv[q] = *(const f32x2*)(bg + 1024 + 2 * q); }
#pragma unroll
        for (int ai = 0; ai < 2; ++ai)
#pragma unroll
            for (int m = 0; m < 4; ++m) {
                f32x2 o[4];
#pragma unroll
                for (int q = 0; q < 4; ++q) {
                    f32x2 gt = (f32x2){acc[ai][0][m][q >> 1][2 * (q & 1)], acc[ai][0][m][q >> 1][2 * (q & 1) + 1]} + bgv[q];
                    f32x2 up = (f32x2){acc[ai][1][m][q >> 1][2 * (q & 1)], acc[ai][1][m][q >> 1][2 * (q & 1) + 1]} + buv[q];
                    gt.x = fminf(gt.x, 7.f); gt.y = fminf(gt.y, 7.f);
                    up.x = __builtin_amdgcn_fmed3f(up.x, -7.f, 7.f); up.y = __builtin_amdgcn_fmed3f(up.y, -7.f, 7.f);
                    const f32x2 ex = gt * (-1.702f * 1.44269504f);
                    f32x2 den; den.x = __builtin_amdgcn_exp2f(ex.x); den.y = __builtin_amdgcn_exp2f(ex.y);
                    den = den + 1.f;
                    f32x2 sg; sg.x = fast_rcp(den.x); sg.y = fast_rcp(den.y);
                    o[q] = (gt * sg) * (up * SC_ACT + SC_ACT);
                }
                u32x2 w;
                { int t = 0; t = __builtin_amdgcn_cvt_pk_fp8_f32(o[0].x, o[0].y, t, false); t = __builtin_amdgcn_cvt_pk_fp8_f32(o[1].x, o[1].y, t, true); w.x = (unsigned)t; }
                { int t = 0; t = __builtin_amdgcn_cvt_pk_fp8_f32(o[2].x, o[2].y, t, false); t = __builtin_amdgcn_cvt_pk_fp8_f32(o[3].x, o[3].y, t, true); w.y = (unsigned)t; }
                *(u32x2*)(ACT + (size_t)(row0 + ai * 128 + m * 16) * 1024 + c0) = w;
            }
        return false;
    }
};
struct EpiDown {
    static constexpr bool PERM = true;
    unsigned char* YK; const float* bd; const int* list; const LAS MoeTbl* tb;
    DI bool operator()(f32x4 (&acc)[2][2][4][2], const Unit& u, int wr, int wc, int fr, int fq) const {
        const int lr0 = (u.pm - tb->rts[u.e]) * 256 + wr * 64 + fr, cnt = tb->cnt[u.e], col0 = u.pn * 256 + wc * 32 + 8 * fq;
        const float* b = bd + (size_t)u.e * 1024 + col0;
        f32x4 bv[2][2];
#pragma unroll
        for (int bj = 0; bj < 2; ++bj) { bv[bj][0] = *(const f32x4*)(b + bj * 128); bv[bj][1] = *(const f32x4*)(b + bj * 128 + 4); }
        int dst[2][4];
#pragma unroll
        for (int ai = 0; ai < 2; ++ai)
#pragma unroll
            for (int m = 0; m < 4; ++m) { const int idx = lr0 + ai * 128 + m * 16; const int d = list[u.e * LISTCAP + (idx < cnt ? idx : cnt - 1)]; dst[ai][m] = (idx < cnt) ? d : 4 * T_; }
#pragma unroll
        for (int ai = 0; ai < 2; ++ai)
#pragma unroll
            for (int m = 0; m < 4; ++m) {
                unsigned char* rowp = YK + (size_t)dst[ai][m] * 1024 + col0;
#pragma unroll
                for (int bj = 0; bj < 2; ++bj) { const f32x4 v0 = (acc[ai][bj][m][0] + bv[bj][0]) * SC_Y, v1 = (acc[ai][bj][m][1] + bv[bj][1]) * SC_Y;
                    u32x2 w; w.x = pk4_fp8(v0[0], v0[1], v0[2], v0[3]); w.y = pk4_fp8(v1[0], v1[1], v1[2], v1[3]);
                    *(u32x2*)(rowp + bj * 128) = w; }
            }
        return false;
    }
};

template <class CM>
DI void transpose_tile(const Frame& F, const float* src, int ldsrc, bf16_t* dst, int K, int k0, int n0, CM cm) {
    LAS float* tile = (LAS float*)F.lds;
    const int r = F.tid >> 4, c4 = (F.tid & 15) * 4;
    const int col0 = cm(n0 + c4);
#pragma unroll
    for (int pass = 0; pass < 2; ++pass) {
        const int rr = r + 32 * pass;
        f32x4 v = {0.f, 0.f, 0.f, 0.f};
        if (col0 >= 0) v = *(const f32x4*)(src + (size_t)(k0 + rr) * ldsrc + col0);
#pragma unroll
        for (int e = 0; e < 4; ++e) tile[rr * 65 + c4 + e] = v[e];
    }
    __syncthreads();
    const int n = F.tid >> 3, k8 = (F.tid & 7) * 8;
    float x[8];
#pragma unroll
    for (int e = 0; e < 8; ++e) x[e] = tile[(k8 + e) * 65 + n];
    u32x4 w; w.x = pk_bf16(x[0], x[1]); w.y = pk_bf16(x[2], x[3]); w.z = pk_bf16(x[4], x[5]); w.w = pk_bf16(x[6], x[7]);
    *(u32x4*)(dst + (size_t)(n0 + n) * K + k0 + k8) = w;
    __syncthreads();
}
struct BigTile { const float* src; unsigned char* dst; int ldsrc, k0, n0, scol, dpitch, bf; };
DI int cm_win(int n) { if (n < 2560) return n < 2048 ? n : n + 16; const int t = (n - 2560) >> 8, j = (n - 2560) & 255; return j < 128 ? 2576 + 128 * t + j : 3600 + 128 * t + (j - 128); }
DI void bt_load(const BigTile& t, int tid, f32x4 (&v)[8]) {
    const int r = tid >> 5, c4 = (tid & 31) * 4;
#pragma unroll
    for (int p = 0; p < 8; ++p) v[p] = *(const f32x4*)(t.src + (size_t)(t.k0 + r + 16 * p) * t.ldsrc + t.scol + c4);
}
DI void bt_store(const BigTile& t, LAS float* tile  , int tid, const f32x4 (&v)[8]) {
    const int r = tid >> 5, c4 = (tid & 31) * 4;
#pragma unroll
    for (int p = 0; p < 8; ++p) *(LAS f32x4*)(tile + (r + 16 * p) * 132 + c4) = v[p];
    __syncthreads();
    const int n = tid >> 2, kq = (tid & 3) * 32;
    float x[32];
#pragma unroll
    for (int e = 0; e < 32; ++e) x[e] = tile[(kq + e) * 132 + n];
    if (t.bf) {
        bf16_t* o = (bf16_t*)t.dst + (size_t)(t.n0 + n) * t.dpitch + t.k0 + kq;
#pragma unroll
        for (int q = 0; q < 4; ++q) { u32x4 w; w.x = pk_bf16(x[8 * q], x[8 * q + 1]); w.y = pk_bf16(x[8 * q + 2], x[8 * q + 3]); w.z = pk_bf16(x[8 * q + 4], x[8 * q + 5]); w.w = pk_bf16(x[8 * q + 6], x[8 * q + 7]);
            *(u32x4*)(o + 8 * q) = w; }
    } else {
        unsigned char* o = t.dst + (size_t)(t.n0 + n) * t.dpitch + t.k0 + kq;
#pragma unroll
        for (int q = 0; q < 2; ++q) { u32x4 w;
            w.x = pk4_fp8(x[16 * q] * SC_W, x[16 * q + 1] * SC_W, x[16 * q + 2] * SC_W, x[16 * q + 3] * SC_W); w.y = pk4_fp8(x[16 * q + 4] * SC_W, x[16 * q + 5] * SC_W, x[16 * q + 6] * SC_W, x[16 * q + 7] * SC_W);
            w.z = pk4_fp8(x[16 * q + 8] * SC_W, x[16 * q + 9] * SC_W, x[16 * q + 10] * SC_W, x[16 * q + 11] * SC_W); w.w = pk4_fp8(x[16 * q + 12] * SC_W, x[16 * q + 13] * SC_W, x[16 * q + 14] * SC_W, x[16 * q + 15] * SC_W);
            *(u32x4*)(o + 16 * q) = w; }
    }
    __syncthreads();
}
constexpr int NWT = 4096 + 2048 + 288 + 64 + 32;
DI BigTile moe_w_tile(const Frame& F, int i) {
    BigTile t; t.bf = 0; t.dpitch = 1024;
    if (i < 4096) { const int e = i >> 7, r = i & 127, nb = r >> 3; t.src = F.in[I_WGU] + (size_t)e * 1024 * 2048; t.dst = F.ws + WS_WGU + (size_t)e * 2048 * 1024; t.ldsrc = 2048; t.k0 = (r & 7) * 128; t.n0 = nb * 128;
        t.scol = (nb & 1) ? 1024 + (nb >> 1) * 128 : (nb >> 1) * 128; }
    else if (i < 6144) { const int j = i - 4096, e = j >> 6, r = j & 63; t.src = F.in[I_WD] + (size_t)e * 1024 * 1024; t.dst = F.ws + WS_WD + (size_t)e * 1024 * 1024; t.ldsrc = 1024; t.k0 = (r & 7) * 128; t.n0 = (r >> 3) * 128; t.scol = t.n0; }
    else if (i < 6432) { const int j = i - 6144; t.bf = 1; t.src = F.in[I_WIN]; t.dst = F.ws + WS_WIN; t.ldsrc = INW; t.k0 = (j & 7) * 128; t.n0 = (j >> 3) * 128; t.scol = cm_win(t.n0); }
    else if (i < 6496) { const int j = i - 6432; t.bf = 1; t.src = F.in[I_WOUT]; t.dst = F.ws + WS_WOUT; t.ldsrc = 1024; t.k0 = (j & 7) * 128; t.n0 = (j >> 3) * 128; t.scol = t.n0; }
    else { const int j = i - 6496; t.bf = 1; t.dpitch = 512; t.src = F.in[I_WUPA]; t.dst = F.ws + WS_WA; t.ldsrc = 1024; t.k0 = (j & 3) * 128; t.n0 = (j >> 2) * 128; t.scol = t.n0; }
    return t;
}
DI void moe_weights(const Frame& F, int rank, int nrank) {
    LAS float* tile = (LAS float*)F.lds;
    const int per = (NWT + nrank - 1) / nrank;
    f32x4 v[3][8];
#define MW_TILE(j) moe_w_tile(F, min(rank + (j) * nrank, NWT - 1))
    { const BigTile t0 = MW_TILE(0); bt_load(t0, F.tid, v[0]); const BigTile t1 = MW_TILE(1); bt_load(t1, F.tid, v[1]); const BigTile t2 = MW_TILE(2); bt_load(t2, F.tid, v[2]); }
    for (int j0 = 0; j0 < per; j0 += 3) {
#pragma unroll
        for (int q = 0; q < 3; ++q) {
            const BigTile t = MW_TILE(j0 + q);
            bt_store(t, tile, F.tid, v[q]);
            const BigTile tn = MW_TILE(j0 + q + 3);
            bt_load(tn, F.tid, v[q]);
        }
    }
#undef MW_TILE
}
struct CmIdent { DI int operator()(int n) const { return n; } };
struct CmWin { DI int operator()(int n) const { if (n < 2560) return n < 2048 ? n : n + 16; const int t = (n - 2560) >> 8, j = (n - 2560) & 255; return j < 128 ? 2576 + 128 * t + j : 3600 + 128 * t + (j - 128); } };
struct CmGu { DI int operator()(int n) const { const int pn = n >> 8, j = n & 255; return j < 128 ? pn * 128 + j : 1024 + pn * 128 + (j - 128); } };

DI void p0_prologue(const Frame& F) {
    unsigned char* ws = F.ws;
    {
        LAS float* Bs = (LAS float*)F.lds;
        LAS float* Ps = Bs + 128 * 64;
        bf16_t* d = (bf16_t*)(ws + WS_WB);
        for (int u = F.bid; u < 4 * 16 * 4; u += F.G) {
            const int g = u >> 6, n0 = ((u >> 2) & 15) * 64, c0 = (u & 3) * 32;
            for (int i = F.tid; i < 128 * 16; i += 512) { const int dd = i >> 4, q = i & 15;
                const f32x4 w = *(const f32x4*)(F.in[I_WUPB] + (size_t)(g * 128 + dd) * 1024 + n0 + 4 * q); const float sc = F.in[I_POOLS][g * 128 + dd];
                *(LAS f32x4*)(Bs + dd * 64 + 4 * q) = w * sc; }
            for (int i = F.tid; i < 32 * 32; i += 512) { const int c = i >> 5, q = i & 31;
                *(LAS f32x4*)(Ps + c * 128 + 4 * q) = *(const f32x4*)(F.in[I_POOLW] + (size_t)g * 128 * 128 + (size_t)(c0 + c) * 128 + 4 * q); }
            __syncthreads();
            const int n = F.lane, cw = F.wid * 4;
            float acc[4] = {0.f, 0.f, 0.f, 0.f};
            for (int dd = 0; dd < 128; dd += 4) {
                const float b0 = Bs[dd * 64 + n], b1 = Bs[(dd + 1) * 64 + n], b2 = Bs[(dd + 2) * 64 + n], b3 = Bs[(dd + 3) * 64 + n];
#pragma unroll
                for (int c = 0; c < 4; ++c) { const f32x4 p = *(const LAS f32x4*)(Ps + (cw + c) * 128 + dd); acc[c] += p[0] * b0 + p[1] * b1 + p[2] * b2 + p[3] * b3; }
            }
            u32x2 w; w.x = pk_bf16(acc[0], acc[1]); w.y = pk_bf16(acc[2], acc[3]);
            *(u32x2*)(d + (size_t)(n0 + n) * 512 + g * 128 + c0 + cw) = w;
            __syncthreads();
        }
    }
    {
        const float* x = F.in[I_X]; const float* gm = F.in[I_GMIX]; bf16_t* hb = (bf16_t*)(ws + WS_H); float* BA = (float*)(ws + WS_BA);
        LAS float* W16 = (LAS float*)F.lds;
        __syncthreads();
        for (int i = F.tid; i < 1024 * 4; i += 512) { const int k = i >> 2, q = i & 3;
            *(LAS f32x4*)(W16 + ((k & 3) * 256 + (k >> 2)) * 20 + 4 * q) = *(const f32x4*)(F.in[I_WIN] + (size_t)k * INW + 2048 + 4 * q); }
        __syncthreads();
        f32x4 g[4];
#pragma unroll
        for (int i = 0; i < 4; ++i) g[i] = *(const f32x4*)(gm + 4 * (F.lane + 64 * i));
        const int lane = F.lane;
        f32x4 vn[4][4];
#define RMS_LOAD(t0) do { _Pragma("unroll") for (int r = 0; r < 4; ++r) { const f32x4* xr = (const f32x4*)(x + (size_t)((t0) + r) * 1024); \
            _Pragma("unroll") for (int i = 0; i < 4; ++i) vn[r][i] = xr[lane + 64 * i]; } } while (0)
        RMS_LOAD((F.bid * 8 + F.wid) * 4);
        for (int tok0 = (F.bid * 8 + F.wid) * 4; tok0 < T_; tok0 += F.G * 8 * 4) {
            f32x4 v[4][4]; float rn[4];
#pragma unroll
            for (int r = 0; r < 4; ++r)
#pragma unroll
                for (int i = 0; i < 4; ++i) v[r][i] = vn[r][i];
            { const int tn = tok0 + F.G * 8 * 4; RMS_LOAD(tn < T_ ? tn : tok0); }
#pragma unroll
            for (int r = 0; r < 4; ++r) { float a = 0.f;
#pragma unroll
                for (int i = 0; i < 4; ++i) a += v[r][i][0] * v[r][i][0] + v[r][i][1] * v[r][i][1] + v[r][i][2] * v[r][i][2] + v[r][i][3] * v[r][i][3];
                rn[r] = __builtin_amdgcn_rsqf(wave_sum(a) * (1.f / 1024.f) + EPS); }
            float acc[4][16];
#pragma unroll
            for (int r = 0; r < 4; ++r)
#pragma unroll
                for (int j = 0; j < 16; ++j) acc[r][j] = 0.f;
#pragma unroll
            for (int i = 0; i < 4; ++i) {
#pragma unroll
                for (int r = 0; r < 4; ++r) { v[r][i] = v[r][i] * rn[r] * g[i];
                    u32x2 w; w.x = pk_bf16(v[r][i][0], v[r][i][1]); w.y = pk_bf16(v[r][i][2], v[r][i][3]);
                    *(u32x2*)(hb + (size_t)(tok0 + r) * 1024 + 4 * (lane + 64 * i)) = w; }
#pragma unroll
                for (int e = 0; e < 4; ++e) {
                    asm volatile("" ::: "memory");
                    const LAS float* wr = W16 + (e * 256 + i * 64 + lane) * 20;
#pragma unroll
                    for (int q = 0; q < 4; ++q) { const f32x4 wv = *(const LAS f32x4*)(wr + 4 * q);
#pragma unroll
                        for (int r = 0; r < 4; ++r)
#pragma unroll
                            for (int z = 0; z < 4; ++z) acc[r][4 * q + z] += v[r][i][e] * wv[z]; }
                }
            }
#define BA_STEP(mask, half) { const bool up = (lane & (mask)) != 0; _Pragma("unroll") for (int r = 0; r < 4; ++r) _Pragma("unroll") for (int j = 0; j < (half); ++j) { \
                const float keep = up ? acc[r][j + (half)] : acc[r][j], send = up ? acc[r][j] : acc[r][j + (half)]; acc[r][j] = keep + __shfl_xor(send, (mask)); } }
            BA_STEP(32, 8) BA_STEP(16, 4) BA_STEP(8, 2) BA_STEP(4, 1)
#undef BA_STEP
#pragma unroll
            for (int r = 0; r < 4; ++r) { float t = acc[r][0]; t += __shfl_xor(t, 1); t += __shfl_xor(t, 2);
                if ((lane & 3) == 0) BA[(size_t)(tok0 + r) * 16 + (lane >> 2)] = t; }
        }
#undef RMS_LOAD
    }
}

constexpr int DLD = 72;
constexpr int DW_X = 0, DW_Y = 9216, DW_ARR = 18432, DW_BYTES = 20352;
constexpr int at_mstart(int j) { return (j + 1) & ~3; }
constexpr int atl_base(int j) { const int a = j >> 2, b = j & 3; return 32 * j - 4 * (2 * a * (a - 1) + a * (b + 1)); }
constexpr int ATL_BLK = 544, BPP = 40, X_PT = 2 * ATL_BLK * 4, Y_T22 = 0, Y_T11T = 32 * BPP * 2, Y_Z = 2 * 32 * BPP * 2;
static_assert(atl_base(32) == ATL_BLK && X_PT + 32 * BPP * 2 <= 9216 && Y_Z + 32 * BPP * 2 <= 9216, "blocked solve LDS map");
constexpr int at_base(int j) { const int a = j >> 2, b = j & 3; return 64 * j - 4 * (2 * a * (a - 1) + a * (b + 1)); }

DI void conv_load(const bf16_t* P, long tok0, bool first_chunk, int pcol, int lane, u32x4 (&xin)[11]) {
    const int tg = lane >> 3, cg = lane & 7;
#pragma unroll
    for (int r = 0; r < 11; ++r) {
        const int tr = 8 * tg + r - 3;
        const bool ok = !(first_chunk && tr < 0);
        u32x4 v = {0u, 0u, 0u, 0u};
        if (ok) v = *(const u32x4*)(P + (size_t)(tok0 + tr) * NP + pcol + 8 * cg);
        xin[r] = v;
    }
}
template <int HALF>
DI void conv_half(const u32x4 (&xin)[11], const float* cw, int lane, float (&out)[4][8]) {
    const int cg = lane & 7;
    f32x4 w[4][2];
#pragma unroll
    for (int j = 0; j < 4; ++j) { w[j][0] = *(const f32x4*)(cw + j * 1536 + 8 * cg); w[j][1] = *(const f32x4*)(cw + j * 1536 + 8 * cg + 4); }
#pragma unroll
    for (int i = 0; i < 4; ++i) {
        float a[8];
#pragma unroll
        for (int e = 0; e < 8; ++e) a[e] = 0.f;
#pragma unroll
        for (int j = 0; j < 4; ++j) {
            const u32x4 x = xin[4 * HALF + i + j];
            const float xv[8] = {bflo(x.x), bfhi(x.x), bflo(x.y), bfhi(x.y), bflo(x.z), bfhi(x.z), bflo(x.w), bfhi(x.w)};
#pragma unroll
            for (int e = 0; e < 8; ++e) a[e] += w[j][e >> 2][e & 3] * xv[e];
        }
#pragma unroll
        for (int e = 0; e < 8; ++e) out[i][e] = siluf_(a[e]);
    }
}
DI void l2norm_half(const float (&v)[4][8], float scale, float (&rs)[4], int lane) {
#pragma unroll
    for (int i = 0; i < 4; ++i) {
        float ss = 0.f;
#pragma unroll
        for (int e = 0; e < 8; ++e) ss += v[i][e] * v[i][e];
        ss += bperm(ss, lane ^ 1); ss += bperm(ss, lane ^ 2); ss += bperm(ss, lane ^ 4);
        rs[i] = __builtin_amdgcn_rsqf(ss + EPS) * scale;
    }
}
DI void write_rowmajor_h(LAS unsigned char* img, const float (&v)[4][8], const float (&rs)[4], int lane, int half) {
    const int tg = lane >> 3, cg = lane & 7;
#pragma unroll
    for (int i = 0; i < 4; ++i) { u32x4 w; w.x = pk_bf16(v[i][0] * rs[i], v[i][1] * rs[i]); w.y = pk_bf16(v[i][2] * rs[i], v[i][3] * rs[i]); w.z = pk_bf16(v[i][4] * rs[i], v[i][5] * rs[i]); w.w = pk_bf16(v[i][6] * rs[i], v[i][7] * rs[i]);
        *(LAS u32x4*)(img + ((8 * tg + 4 * half + i) * DLD + 8 * cg) * 2) = w; }
}
DI void write_transposed_h(LAS unsigned char* img, const float (&v)[4][8], const float (&rs)[4], int lane, int half) {
    const int tg = lane >> 3, cg = lane & 7;
#pragma unroll
    for (int e = 0; e < 8; ++e) { u32x2 w; w.x = pk_bf16(v[0][e] * rs[0], v[1][e] * rs[1]); w.y = pk_bf16(v[2][e] * rs[2], v[3][e] * rs[3]);
        *(LAS u32x2*)(img + ((8 * cg + e) * DLD + 8 * tg + 4 * half) * 2) = w; }
}
DI bf16x8 read_frag(const LAS unsigned char* img, int rt, int s, int fr, int g) {
    const LAS unsigned char* p = img + ((16 * rt + fr) * DLD + 32 * s + 4 * g) * 2;
    return mk8(*(const LAS u32x2*)p, *(const LAS u32x2*)(p + 32));
}

DI bf16x8 read_frag32(const LAS unsigned char* img, int rt, int fr, int g) {
    const LAS unsigned char* p = img + ((16 * rt + fr) * BPP + 4 * g) * 2;
    return mk8(*(const LAS u32x2*)p, *(const LAS u32x2*)(p + 32));
}
DI void delta_prep_unit(unsigned char* ws_, const float* convw, const float* alog, const float* dtb, int parkslot, LAS unsigned char* wl, int unit) {
#define SEC() int lane = threadIdx.x & 63; asm volatile("" : "+v"(lane)); const int fr = lane & 15, g = lane >> 4; (void)fr; (void)g; \
    u32x4* Mb = (u32x4*)(dl + DL_M) + (size_t)dl_cmajor(unit) * 8 * 64 + lane; u32x4* Qb = (u32x4*)(dl + DL_Q) + (size_t)unit * 8 * 64 + lane; \
    u32x2* Nb = (u32x2*)(dl + DL_N) + (size_t)dl_cmajor(unit) * 16 * 64 + lane; u32x2* Ob = (u32x2*)(dl + DL_O) + (size_t)unit * 16 * 64 + lane; \
    u32x4* Sbp = (u32x4*)(dl + DL_S) + (size_t)dl_cmajor(unit) * 8 * 64 + lane; u32x4* Kpark = (u32x4*)(ws_ + WS_PARK) + (size_t)parkslot * 8 * 64 + lane; \
    (void)Mb; (void)Qb; (void)Nb; (void)Ob; (void)Sbp; (void)Kpark;
    unsigned char* dl = ws_ + WS_DELTA;
    const int bh = unit >> 6, c = unit & 63, b = bh >> 3, h = bh & 7;
    const long tok0 = (long)b * L_ + c * 64;
    const bool first = (c == 0);
    const bf16_t* P = (const bf16_t*)(ws_ + WS_P);
    LAS unsigned char* X = wl + DW_X; LAS unsigned char* Y = wl + DW_Y;
    LAS float* sG = (LAS float*)(wl + DW_ARR); LAS float* sBeta = sG + 64; LAS float* sBE = sG + 128; LAS float* sEL = sG + 192; LAS float* sEG = sG + 256;
    const f32x4 z4 = {0.f, 0.f, 0.f, 0.f};
    u32x4 xk[11];
    { SEC(); conv_load(P, tok0, first, PC_K + h * 64, lane, xk); }
    float glast;
    {
        SEC();
        const float* BA = (const float*)(ws_ + WS_BA) + (size_t)(tok0 + lane) * 16;
        const float braw = BA[h], araw = BA[8 + h];
        const float beta = sigmoidf_(braw);
        const float sp = __logf(1.f + __expf(araw + dtb[h]));
        float G = -__expf(alog[h]) * sp;
#pragma unroll
        for (int d = 1; d < 64; d <<= 1) { const float t = bperm(G, lane >= d ? lane - d : lane); if (lane >= d) G += t; }
        glast = __int_as_float(__builtin_amdgcn_readlane(__float_as_int(G), 63));
        const float eg = __expf(G);
        sG[lane] = G; sBeta[lane] = beta; sBE[lane] = beta * eg; sEL[lane] = __expf(glast - G); sEG[lane] = eg;
        wsync();
    }
    const float eGlast = __expf(glast);
    bf16x8 qkP[2][4], vbT[4][2];
    bf16x8 kA[4][2];
    {
        SEC();
        { float v[4][8], rs[4]; conv_half<0>(xk, convw + 512 + h * 64, lane, v); l2norm_half(v, 1.f, rs, lane); write_transposed_h(X, v, rs, lane, 0); write_rowmajor_h(Y, v, rs, lane, 0); }
        { float v[4][8], rs[4]; conv_half<1>(xk, convw + 512 + h * 64, lane, v); l2norm_half(v, 1.f, rs, lane); write_transposed_h(X, v, rs, lane, 1); write_rowmajor_h(Y, v, rs, lane, 1); }
        wsync();
#pragma unroll
        for (int t = 0; t < 4; ++t)
#pragma unroll
            for (int s = 0; s < 2; ++s) { Kpark[(t * 2 + s) * 64] = __builtin_bit_cast(u32x4, read_frag(X, t, s, fr, g)); kA[t][s] = read_frag(Y, t, s, fr, g); }
        wsync();
    }
    u32x4 xq[11];
    {
        SEC();
        conv_load(P, tok0, first, PC_Q + h * 64, lane, xq);
        LAS float* AT = (LAS float*)X;
        f32x4 Gr[4], Br[4]; float Gc[4];
#pragma unroll
        for (int t = 0; t < 4; ++t) { Gr[t] = *(const LAS f32x4*)(sG + 16 * t + 4 * g); Br[t] = *(const LAS f32x4*)(sBeta + 16 * t + 4 * g); Gc[t] = sG[16 * t + fr]; }
#pragma unroll
        for (int nt = 0; nt < 4; ++nt)
#pragma unroll
            for (int mt = nt; mt < 4; ++mt) {
                f32x4 a = z4;
#pragma unroll
                for (int s = 0; s < 2; ++s) a = mfma16(kA[mt][s], kA[nt][s], a);
                const int j = 16 * nt + fr, m0 = 16 * mt + 4 * g;
                if ((mt >> 1) == (nt >> 1)) {
                    const int jl = j & 31, m0l = m0 & 31;
                    const int ms = (jl + 1) & ~3, ja = jl >> 2, jb = jl & 3, base = (nt >> 1) * ATL_BLK + 32 * jl - 4 * (2 * ja * (ja - 1) + ja * (jb + 1));
                    f32x4 o;
#pragma unroll
                    for (int r = 0; r < 4; ++r) o[r] = (m0 + r > j) ? Br[mt][r] * a[r] * __expf(Gr[mt][r] - Gc[nt]) : 0.f;
                    if (m0l >= ms) *(LAS f32x4*)(AT + base + m0l - ms) = o;
                } else {
                    f32x4 o;
#pragma unroll
                    for (int r = 0; r < 4; ++r) o[r] = Br[mt][r] * a[r] * __expf(Gr[mt][r] - Gc[nt]);
                    u32x2 w; w.x = pk_bf16(o[0], o[1]); w.y = pk_bf16(o[2], o[3]);
                    *(LAS u32x2*)(X + X_PT + (j * BPP + m0 - 32) * 2) = w;
                }
            }
    }
    u32x4 xv[11];
    {
        SEC();
        conv_load(P, tok0, first, PC_V + h * 64, lane, xv);
        { float v[4][8], rs[4]; conv_half<0>(xq, convw + h * 64, lane, v); l2norm_half(v, 0.125f, rs, lane); write_rowmajor_h(Y, v, rs, lane, 0); }
        { float v[4][8], rs[4]; conv_half<1>(xq, convw + h * 64, lane, v); l2norm_half(v, 0.125f, rs, lane); write_rowmajor_h(Y, v, rs, lane, 1); }
        wsync();
        f32x4 Gr[4]; float Gc[4];
#pragma unroll
        for (int t = 0; t < 4; ++t) { Gr[t] = *(const LAS f32x4*)(sG + 16 * t + 4 * g); Gc[t] = sG[16 * t + fr]; }
#pragma unroll
        for (int nt = 0; nt < 4; ++nt) {
            bf16x8 qBn[2];
#pragma unroll
            for (int s = 0; s < 2; ++s) { qBn[s] = read_frag(Y, nt, s, fr, g); Qb[(nt * 2 + s) * 64] = __builtin_bit_cast(u32x4, qBn[s]); }
            f32x4 tl[4];
#pragma unroll
            for (int mt = 0; mt < 4; ++mt) {
                f32x4 a = z4;
                if (mt <= nt) {
#pragma unroll
                    for (int s = 0; s < 2; ++s) a = mfma16(kA[mt][s], qBn[s], a);
                    const int cC = 16 * nt + fr, m0 = 16 * mt + 4 * g;
#pragma unroll
                    for (int r = 0; r < 4; ++r) a[r] = (m0 + r <= cC) ? a[r] * __expf(Gc[nt] - Gr[mt][r]) : 0.f;
                }
                tl[mt] = a;
            }
            qkP[0][nt] = pack2(tl[0], tl[1]); qkP[1][nt] = pack2(tl[2], tl[3]);
        }
        wsync();
    }
    {
        SEC();
        { float v[4][8]; conv_half<0>(xv, convw + 1024 + h * 64, lane, v); const f32x4 b0 = *(const LAS f32x4*)(sBeta + 8 * (lane >> 3)); const float rs[4] = {b0[0], b0[1], b0[2], b0[3]}; write_transposed_h(Y, v, rs, lane, 0); }
        { float v[4][8]; conv_half<1>(xv, convw + 1024 + h * 64, lane, v); const f32x4 b0 = *(const LAS f32x4*)(sBeta + 8 * (lane >> 3) + 4); const float rs[4] = {b0[0], b0[1], b0[2], b0[3]}; write_transposed_h(Y, v, rs, lane, 1); }
        wsync();
    }
    bf16x8 kT[4][2];
    {
        SEC();
        const u32x4* Kre_ = Kpark; asm volatile("" : "+v"(Kre_)); const __attribute__((address_space(1))) u32x4* Kre = (const __attribute__((address_space(1))) u32x4*)Kre_;
#pragma unroll
        for (int nt = 0; nt < 4; ++nt)
#pragma unroll
            for (int s = 0; s < 2; ++s) { vbT[nt][s] = read_frag(Y, nt, s, fr, g); kT[nt][s] = __builtin_bit_cast(bf16x8, Kre[(nt * 2 + s) * 64]); }
        wsync();
        const int li = lane & 31, hb = lane >> 5;
        float Tl[32];
        {
            const unsigned at0 = (unsigned)(size_t)X + (unsigned)hb * (ATL_BLK * 4);
#pragma unroll
            for (int j = 31; j >= 0; --j) {
                float a = (li == j) ? 1.f : 0.f;
                unsigned aj = at0;
                if (j < 30) asm volatile("" : "+v"(aj), "+v"(Tl[j + 2]));
                const LAS float* AT = (const LAS float*)aj;
#pragma unroll
                for (int m4 = at_mstart(j); m4 < 32; m4 += 4) {
                    const f32x4 av = *(const LAS f32x4*)(AT + atl_base(j) + m4 - at_mstart(j));
#pragma unroll
                    for (int e = 0; e < 4; ++e) if (m4 + e > j) a = __builtin_fmaf(-Tl[m4 + e], av[e], a);
                }
                Tl[j] = a;
            }
        }
        if (hb) {
#pragma unroll
            for (int q = 0; q < 4; ++q) { u32x4 w; w.x = pk_bf16(Tl[8 * q], Tl[8 * q + 1]); w.y = pk_bf16(Tl[8 * q + 2], Tl[8 * q + 3]); w.z = pk_bf16(Tl[8 * q + 4], Tl[8 * q + 5]); w.w = pk_bf16(Tl[8 * q + 6], Tl[8 * q + 7]);
                *(LAS u32x4*)(Y + Y_T22 + (li * BPP + 8 * q) * 2) = w; }
        } else {
#pragma unroll
            for (int c = 0; c < 32; ++c) *(LAS unsigned short*)(Y + Y_T11T + (c * BPP + li) * 2) = (unsigned short)(pk_bf16(Tl[c], 0.f) & 0xffffu);
        }
        wsync();
#pragma unroll
        for (int mt = 0; mt < 2; ++mt)
#pragma unroll
            for (int nt = 0; nt < 2; ++nt) {
                const f32x4 d = mfma16(read_frag32(X + X_PT, mt, fr, g), read_frag32(Y + Y_T22, nt, fr, g), z4);
                u32x2 w; w.x = pk_bf16(d[0], d[1]); w.y = pk_bf16(d[2], d[3]);
                *(LAS u32x2*)(Y + Y_Z + ((16 * nt + fr) * BPP + 16 * mt + 4 * g) * 2) = w;
            }
        wsync();
        f32x4 t21[2][2];
#pragma unroll
        for (int mt = 0; mt < 2; ++mt)
#pragma unroll
            for (int nt = 0; nt < 2; ++nt) t21[mt][nt] = -mfma16(read_frag32(Y + Y_T11T, mt, fr, g), read_frag32(Y + Y_Z, nt, fr, g), z4);
        wsync();
        const int cb = 32 * hb;
#pragma unroll
        for (int q = 0; q < 4; ++q) {
            const f32x4 s0 = *(const LAS f32x4*)(sBE + cb + 8 * q), s1 = *(const LAS f32x4*)(sBE + cb + 8 * q + 4);
            u32x4 w, w2;
            w.x = pk_bf16(Tl[8 * q], Tl[8 * q + 1]); w.y = pk_bf16(Tl[8 * q + 2], Tl[8 * q + 3]); w.z = pk_bf16(Tl[8 * q + 4], Tl[8 * q + 5]); w.w = pk_bf16(Tl[8 * q + 6], Tl[8 * q + 7]);
            w2.x = pk_bf16(Tl[8 * q] * s0[0], Tl[8 * q + 1] * s0[1]); w2.y = pk_bf16(Tl[8 * q + 2] * s0[2], Tl[8 * q + 3] * s0[3]);
            w2.z = pk_bf16(Tl[8 * q + 4] * s1[0], Tl[8 * q + 5] * s1[1]); w2.w = pk_bf16(Tl[8 * q + 6] * s1[2], Tl[8 * q + 7] * s1[3]);
            *(LAS u32x4*)(X + (lane * DLD + cb + 8 * q) * 2) = w;
            *(LAS u32x4*)(Y + (lane * DLD + cb + 8 * q) * 2) = w2;
            if (!hb) { const u32x4 zz = {0u, 0u, 0u, 0u}; *(LAS u32x4*)(X + (lane * DLD + 32 + 8 * q) * 2) = zz; *(LAS u32x4*)(Y + (lane * DLD + 32 + 8 * q) * 2) = zz; }
        }
#pragma unroll
        for (int mt = 0; mt < 2; ++mt)
#pragma unroll
            for (int nt = 0; nt < 2; ++nt) {
                const f32x4 sc = *(const LAS f32x4*)(sBE + 16 * mt + 4 * g);
                const f32x4 d = t21[mt][nt], d2 = d * sc;
                u32x2 w, w2; w.x = pk_bf16(d[0], d[1]); w.y = pk_bf16(d[2], d[3]); w2.x = pk_bf16(d2[0], d2[1]); w2.y = pk_bf16(d2[2], d2[3]);
                *(LAS u32x2*)(X + ((32 + 16 * nt + fr) * DLD + 16 * mt + 4 * g) * 2) = w;
                *(LAS u32x2*)(Y + ((32 + 16 * nt + fr) * DLD + 16 * mt + 4 * g) * 2) = w2;
            }
        wsync();
    }
    SEC();
    f32x4 ELr[4]; float EGc[4];
#pragma unroll
    for (int t = 0; t < 4; ++t) { ELr[t] = *(const LAS f32x4*)(sEL + 16 * t + 4 * g); EGc[t] = sEG[16 * t + fr]; }
    {
#pragma unroll
        for (int nt = 0; nt < 4; ++nt) {
            f32x4 Ut[4];
#pragma unroll
            for (int mt = 0; mt < 4; ++mt) { f32x4 a = z4;
#pragma unroll
                for (int s = 0; s < 2; ++s) a = mfma16(read_frag(X, mt, s, fr, g), vbT[nt][s], a);
                Ut[mt] = a; }
            bf16x8 Ub[2], Usb[2];
#pragma unroll
            for (int s = 0; s < 2; ++s) { Ub[s] = pack2(Ut[2 * s], Ut[2 * s + 1]); Usb[s] = pack2(Ut[2 * s] * ELr[2 * s], Ut[2 * s + 1] * ELr[2 * s + 1]); }
#pragma unroll
            for (int mt = 0; mt < 4; ++mt) { f32x4 a = z4;
#pragma unroll
                for (int s = 0; s < 2; ++s) a = mfma16(kT[mt][s], Usb[s], a);
                u32x2 nw; nw.x = pk_bf16(a[0], a[1]); nw.y = pk_bf16(a[2], a[3]); __builtin_nontemporal_store(nw, &Nb[(mt * 4 + nt) * 64]); }
#pragma unroll
            for (int n2 = 0; n2 < 4; ++n2) { f32x4 a = z4;
#pragma unroll
                for (int s = 0; s < 2; ++s) a = mfma16(Ub[s], qkP[s][n2], a);
                u32x2 ow; ow.x = pk_bf16(a[0], a[1]); ow.y = pk_bf16(a[2], a[3]); __builtin_nontemporal_store(ow, &Ob[(nt * 4 + n2) * 64]); }
            asm volatile("" ::: "memory");
        }
    }
    {
        u32x4 qbv[2][4];
        const u32x4* Qre_ = Qb; asm volatile("" : "+v"(Qre_)); const __attribute__((address_space(1))) u32x4* Qre = (const __attribute__((address_space(1))) u32x4*)Qre_;
#pragma unroll
        for (int s2 = 0; s2 < 2; ++s2)
#pragma unroll
            for (int nt = 0; nt < 4; ++nt) qbv[s2][nt] = Qre[(nt * 2 + s2) * 64];
#pragma unroll
        for (int s2 = 0; s2 < 2; ++s2) {
            bf16x8 Wb[2][2], Wsb[2][2];
#pragma unroll
            for (int w = 0; w < 2; ++w) {
                f32x4 Wt[4];
#pragma unroll
                for (int mt = 0; mt < 4; ++mt) { f32x4 a = z4;
#pragma unroll
                    for (int s = 0; s < 2; ++s) a = mfma16(read_frag(Y, mt, s, fr, g), kT[2 * s2 + w][s], a);
                    Wt[mt] = a; }
#pragma unroll
                for (int s = 0; s < 2; ++s) { Wb[w][s] = pack2(Wt[2 * s], Wt[2 * s + 1]); Wsb[w][s] = pack2(Wt[2 * s] * ELr[2 * s], Wt[2 * s + 1] * ELr[2 * s + 1]); }
            }
#pragma unroll
            for (int nt = 0; nt < 4; ++nt) {
                f32x4 mv[2], qv[2];
                const u32x4 qb = qbv[s2][nt];
#pragma unroll
                for (int w = 0; w < 2; ++w) {
                    f32x4 a = z4, q = z4;
#pragma unroll
                    for (int s = 0; s < 2; ++s) { a = mfma16(Wsb[w][s], kT[nt][s], a); q = mfma16(Wb[w][s], qkP[s][nt], q); }
                    const int dkp0 = 16 * (2 * s2 + w) + 4 * g, dk = 16 * nt + fr;
                    const unsigned q01 = w ? qb.z : qb.x, q23 = w ? qb.w : qb.y;
                    const float qg[4] = {bflo(q01), bfhi(q01), bflo(q23), bfhi(q23)};
#pragma unroll
                    for (int r = 0; r < 4; ++r) { mv[w][r] = ((dkp0 + r == dk) ? eGlast : 0.f) - a[r]; qv[w][r] = qg[r] * EGc[nt] - q[r]; }
                }
                __builtin_nontemporal_store(__builtin_bit_cast(u32x4, pack2(mv[0], mv[1])), &Mb[(nt * 2 + s2) * 64]);
                __builtin_nontemporal_store(__builtin_bit_cast(u32x4, pack2(qv[0], qv[1])), &Qb[(nt * 2 + s2) * 64]);
            }
            asm volatile("" ::: "memory");
        }
    }
}
#undef SEC
template <int W>
DI void pool_item(const bf16_t* P, bf16_t* PM, int tb, int c8) {
    const int t0 = tb * 8, tin = t0 & (L_ - 1);
    u32x4 x[W + 7];
#pragma unroll
    for (int r = 0; r < W + 7; ++r) {
        const int rel = r - (W - 1);
        u32x4 v = {0u, 0u, 0u, 0u};
        if (tin + rel >= 0) v = *(const u32x4*)(P + (size_t)(t0 + rel) * NP + PC_U + 8 * c8);
        x[r] = v;
    }
    float s[8];
#pragma unroll
    for (int e = 0; e < 8; ++e) s[e] = 0.f;
#pragma unroll
    for (int r = 0; r < W - 1; ++r) { s[0] += bflo(x[r].x); s[1] += bfhi(x[r].x); s[2] += bflo(x[r].y); s[3] += bfhi(x[r].y); s[4] += bflo(x[r].z); s[5] += bfhi(x[r].z); s[6] += bflo(x[r].w); s[7] += bfhi(x[r].w); }
#pragma unroll
    for (int i = 0; i < 8; ++i) {
        const u32x4 c = x[i + W - 1];
        const float u0[8] = {bflo(c.x), bfhi(c.x), bflo(c.y), bfhi(c.y), bflo(c.z), bfhi(c.z), bflo(c.w), bfhi(c.w)};
#pragma unroll
        for (int e = 0; e < 8; ++e) s[e] += u0[e];
        const int cnt = (tin + i + 1 < W) ? tin + i + 1 : W;
        const float inv = 1.f / (float)cnt;
        u32x4 o; o.x = pk_bf16(s[0] * inv - u0[0], s[1] * inv - u0[1]); o.y = pk_bf16(s[2] * inv - u0[2], s[3] * inv - u0[3]);
        o.z = pk_bf16(s[4] * inv - u0[4], s[5] * inv - u0[5]); o.w = pk_bf16(s[6] * inv - u0[6], s[7] * inv - u0[7]);
        *(u32x4*)(PM + (size_t)(t0 + i) * 512 + 8 * c8) = o;
        const u32x4 d = x[i];
        s[0] -= bflo(d.x); s[1] -= bfhi(d.x); s[2] -= bflo(d.y); s[3] -= bfhi(d.y); s[4] -= bflo(d.z); s[5] -= bfhi(d.z); s[6] -= bflo(d.w); s[7] -= bfhi(d.w);
    }
}
DI void pool_prep(const Frame& F) {
    const bf16_t* P = (const bf16_t*)(F.ws + WS_P); bf16_t* PM = (bf16_t*)(F.ws + WS_PM);
    for (int wi = F.bid * 8 + F.wid; wi < 4 * (T_ / 32); wi += F.G * 8) {
        const int grp = wi & 3, tb = (wi >> 2) * 4 + (F.lane >> 4), c8 = grp * 16 + (F.lane & 15);
        if (grp == 0) pool_item<2>(P, PM, tb, c8);
        else if (grp == 1) pool_item<4>(P, PM, tb, c8);
        else if (grp == 2) pool_item<8>(P, PM, tb, c8);
        else pool_item<16>(P, PM, tb, c8);
    }
}

constexpr int SC_NS = 14, SC_SLOT = 10240, SC_FLAGS = SC_NS * SC_SLOT;
DI void delta_scan(const Frame& F) {
    const int lane = F.lane;
    LAS unsigned char* ring = F.lds;
    volatile LAS int* ready = (volatile LAS int*)(F.lds + SC_FLAGS); volatile LAS int* consumed = ready + 64;
    if (F.tid < 65) ready[F.tid] = 0;
    __syncthreads();
    unsigned char* dl = F.ws + WS_DELTA;
    for (int job = F.bid; job < 256; job += F.G) {
        const int chain = (job & 7) * 8 + (job >> 5), nt = (job >> 3) & 3;
        const u32x4* Mb = (const u32x4*)(dl + DL_M) + (size_t)chain * 8 * 64 + lane;
        const u32x2* Nb = (const u32x2*)(dl + DL_N) + (size_t)chain * 16 * 64 + lane;
        if (F.wid == 0) {
            u32x4* Sb = (u32x4*)(dl + DL_S) + (size_t)chain * 8 * 64 + lane;
            f32x4 S[4];
#pragma unroll
            for (int m = 0; m < 4; ++m) S[m] = (f32x4){0.f, 0.f, 0.f, 0.f};
            u32x4 Mq[8]; u32x2 Nr[4]; int nready;
            { unsigned sp = 0; while (ready[0] == 0) { __builtin_amdgcn_s_sleep(1); if (++sp > (1u << 22)) break; } }
            asm volatile("" ::: "memory");
#pragma unroll
            for (int f = 0; f < 8; ++f) Mq[f] = *(const LAS u32x4*)(ring + lane * 16 + f * 1024);
#pragma unroll
            for (int m = 0; m < 4; ++m) Nr[m] = *(const LAS u32x2*)(ring + 8192 + lane * 8 + m * 512);
            nready = ready[1];
            wsync();
            if (lane == 0) *consumed = 1;
            for (int c = 0; c < 64; ++c) {
                bf16x8 Sf[2];
#pragma unroll
                for (int s = 0; s < 2; ++s) { Sf[s] = pack2(S[2 * s], S[2 * s + 1]); __builtin_nontemporal_store(__builtin_bit_cast(u32x4, Sf[s]), &Sb[((size_t)c * 64 * 8 + nt * 2 + s) * 64]); }
#pragma unroll
                for (int m = 0; m < 4; ++m) { f32x4 a = {bflo(Nr[m].x), bfhi(Nr[m].x), bflo(Nr[m].y), bfhi(Nr[m].y)};
#pragma unroll
                    for (int s = 0; s < 2; ++s) a = mfma16(__builtin_bit_cast(bf16x8, Mq[m * 2 + s]), Sf[s], a);
                    S[m] = a; }
                __builtin_amdgcn_sched_barrier(0);
                if (c + 1 < 64) {
                    if (nready == 0) { unsigned sp = 0; while (ready[c + 1] == 0) { __builtin_amdgcn_s_sleep(1); if (++sp > (1u << 22)) break; } }
                    asm volatile("" ::: "memory");
                    const LAS unsigned char* slot = ring + ((c + 1) % SC_NS) * SC_SLOT;
#pragma unroll
                    for (int f = 0; f < 8; ++f) Mq[f] = *(const LAS u32x4*)(slot + lane * 16 + f * 1024);
#pragma unroll
                    for (int m = 0; m < 4; ++m) Nr[m] = *(const LAS u32x2*)(slot + 8192 + lane * 8 + m * 512);
                    nready = ready[(c + 2) & 63];
                    wsync();
                    if (lane == 0) *consumed = c + 2;
                }
            }
        } else {
            for (int c = F.wid - 1; c < 64; c += 7) {
                u32x4 Mq[8]; u32x2 Nq[4];
#pragma unroll
                for (int f = 0; f < 8; ++f) Mq[f] = Mb[((size_t)c * 64 * 8 + f) * 64];
#pragma unroll
                for (int m = 0; m < 4; ++m) Nq[m] = Nb[((size_t)c * 64 * 16 + m * 4 + nt) * 64];
                { unsigned sp = 0; while (c - *consumed >= SC_NS) { __builtin_amdgcn_s_sleep(1); if (++sp > (1u << 22)) break; } }
                asm volatile("" ::: "memory");
                LAS unsigned char* slot = ring + (c % SC_NS) * SC_SLOT + lane * 16;
#pragma unroll
                for (int f = 0; f < 8; ++f) *(LAS u32x4*)(slot + f * 1024) = Mq[f];
#pragma unroll
                for (int m = 0; m < 4; ++m) *(LAS u32x2*)(ring + (c % SC_NS) * SC_SLOT + 8192 + lane * 8 + m * 512) = Nq[m];
                wsync();
                if (lane == 0) ready[c] = 1;
            }
        }
    }
}

struct DoutIn { bf16x8 Sf[4][2], Qf[4][2]; u32x2 Ot[16]; };
DI void delta_out_load(const Frame& F, int lane, int unit, DoutIn& d) {
    unsigned char* dl = F.ws + WS_DELTA;
    const u32x4* Qb = (const u32x4*)(dl + DL_Q) + (size_t)unit * 8 * 64 + lane;
    const u32x4* Sb = (const u32x4*)(dl + DL_S) + (size_t)dl_cmajor(unit) * 8 * 64 + lane;
    const u32x2* Ob = (const u32x2*)(dl + DL_O) + (size_t)unit * 16 * 64 + lane;
#pragma unroll
    for (int t = 0; t < 4; ++t)
#pragma unroll
        for (int s = 0; s < 2; ++s) { d.Sf[t][s] = __builtin_bit_cast(bf16x8, Sb[(t * 2 + s) * 64]); d.Qf[t][s] = __builtin_bit_cast(bf16x8, Qb[(t * 2 + s) * 64]); }
#pragma unroll
    for (int t = 0; t < 16; ++t) d.Ot[t] = Ob[t * 64];
}
DI void dout_z_issue(const Frame& F, int lane, int unit, u32x4 (&zr)[8]) {
    const int bh = unit >> 6, c = unit & 63, b = bh >> 3, h = bh & 7;
    const bf16_t* P = (const bf16_t*)(F.ws + WS_P) + ((size_t)b * L_ + c * 64) * NP + PC_Z + h * 64 + 8 * (lane & 7);
#pragma unroll
    for (int p = 0; p < 8; ++p) zr[p] = *(const u32x4*)(P + (size_t)(8 * p + (lane >> 3)) * NP);
}
DI void dout_z_put(LAS unsigned char* img, int lane, const u32x4 (&zr)[8]) {
#pragma unroll
    for (int p = 0; p < 8; ++p) *(LAS u32x4*)(img + ((8 * p + (lane >> 3)) * DLD + 8 * (lane & 7)) * 2) = zr[p];
}
DI void delta_out_compute(const Frame& F, int lane, int unit, const DoutIn& d, LAS unsigned char* img, const f32x4 (&dn)[4]) {
    asm volatile("" : "+v"(lane));
    const int fr = lane & 15, g = lane >> 4;
    const int bh = unit >> 6, c = unit & 63, b = bh >> 3, h = bh & 7;
    const long tok0 = (long)b * L_ + c * 64;
    bf16_t* OA = (bf16_t*)(F.ws + WS_OA);
#pragma unroll
    for (int nt = 0; nt < 4; ++nt) {
        LAS unsigned char* zrow = img + ((16 * nt + fr) * DLD + 4 * g) * 2;
        u32x2 zz[4];
#pragma unroll
        for (int mt = 0; mt < 4; ++mt) zz[mt] = *(const LAS u32x2*)(zrow + 32 * mt);
        f32x4 o[4]; float ss = 0.f;
#pragma unroll
        for (int mt = 0; mt < 4; ++mt) { const u32x2 ob = d.Ot[mt * 4 + nt]; f32x4 a = {bflo(ob.x), bfhi(ob.x), bflo(ob.y), bfhi(ob.y)};
#pragma unroll
            for (int s = 0; s < 2; ++s) a = mfma16(d.Sf[mt][s], d.Qf[nt][s], a);
            o[mt] = a; ss += a[0] * a[0] + a[1] * a[1] + a[2] * a[2] + a[3] * a[3]; }
        ss += __shfl_xor(ss, 16); ss += __shfl_xor(ss, 32);
        const float rn = __builtin_amdgcn_rsqf(ss * (1.f / 64.f) + EPS);
#pragma unroll
        for (int mt = 0; mt < 4; ++mt) {
            const float z[4] = {bflo(zz[mt].x), bfhi(zz[mt].x), bflo(zz[mt].y), bfhi(zz[mt].y)};
            float y[4];
#pragma unroll
            for (int r = 0; r < 4; ++r) y[r] = o[mt][r] * rn * dn[mt][r] * siluf_(z[r]);
            u32x2 w; w.x = pk_bf16(y[0], y[1]); w.y = pk_bf16(y[2], y[3]);
            *(LAS u32x2*)(zrow + 32 * mt) = w;
        }
    }
    wsync();
#pragma unroll
    for (int p = 0; p < 8; ++p) {
        const int row = 8 * p + (lane >> 3);
        const u32x4 v = *(const LAS u32x4*)(img + (row * DLD + 8 * (lane & 7)) * 2);
        *(u32x4*)(OA + (size_t)(tok0 + row) * 512 + h * 64 + 8 * (lane & 7)) = v;
    }
}
DI void delta_out(const Frame& F) {
    const int u0 = F.bid * 8 + F.wid;
    LAS unsigned char* imgA = F.lds + F.wid * DW_BYTES; LAS unsigned char* imgB = imgA + 9216;
    for (int u = u0; u < 4096; u += F.G * 8 * 2) {
        const int u2 = u + F.G * 8; const bool has2 = u2 < 4096;
        int lane = F.lane; asm volatile("" : "+v"(lane));
        f32x4 dn[4];
#pragma unroll
        for (int mt = 0; mt < 4; ++mt) dn[mt] = *(const f32x4*)(F.in[I_DNN] + 16 * mt + 4 * (lane >> 4));
        u32x4 zA[8], zB[8];
        dout_z_issue(F, lane, u, zA); dout_z_issue(F, lane, has2 ? u2 : u, zB);
        asm volatile("" ::: "memory");
        DoutIn A, B;
        delta_out_load(F, lane, u, A);
        dout_z_put(imgA, lane, zA); dout_z_put(imgB, lane, zB);
        asm volatile("" ::: "memory");
        __builtin_amdgcn_sched_barrier(0);
        delta_out_load(F, lane, has2 ? u2 : u, B);
        __builtin_amdgcn_sched_barrier(0);
        wsync();
        delta_out_compute(F, lane, u, A, imgA, dn);
        if (has2) delta_out_compute(F, lane, u2, B, imgB, dn);
        wsync();
    }
}

constexpr int RT_PITCH = 36;
constexpr int RT_CNT = 1024 * RT_PITCH * 4;
DI void p7_router(const Frame& F) {
    LAS float* W = (LAS float*)F.lds;
    LAS int* lcount = (LAS int*)(F.lds + RT_CNT); LAS int* lbase = lcount + 32; LAS int* rec_e = lbase + 32; LAS int* rec_s = rec_e + 512; LAS float* rec_w = (LAS float*)(rec_s + 512);
    const float* x1 = F.in[I_X]; const bf16_t* dx = (const bf16_t*)(F.ws + WS_PM); unsigned char* h2 = F.ws + WS_H;
    int* gcount = (int*)(F.ws + WS_CTL + CW_CNT); int* list = (int*)(F.ws + WS_LIST); float* topw = (float*)(F.ws + WS_TOPW);
    const int lane = F.lane;
    for (int i = F.tid; i < 1024 * 8; i += 512) { const int k = i >> 3, q = i & 7; const f32x4 v = *(const f32x4*)(F.in[I_WR] + k * 32 + q * 4);
        *(LAS f32x4*)(W + ((k & 3) * 256 + (k >> 2)) * RT_PITCH + q * 4) = v; }
    f32x4 gf[4];
#pragma unroll
    for (int i = 0; i < 4; ++i) gf[i] = *(const f32x4*)(F.in[I_GFFN] + 4 * (lane + 64 * i));
    const float brt = F.in[I_BR][lane >> 1];
    for (int chunk = F.bid; chunk < T_ / 128; chunk += F.G) {
        if (F.tid < 32) lcount[F.tid] = 0;
        __syncthreads();
        const int tokc = chunk * 128;
        f32x4 vn[4]; u32x2 dn2[4];
        { const int tok = tokc + F.wid * 16;
#pragma unroll
          for (int i = 0; i < 4; ++i) { dn2[i] = *(const u32x2*)(dx + (size_t)tok * 1024 + 4 * (lane + 64 * i)); vn[i] = *(const f32x4*)(x1 + (size_t)tok * 1024 + 4 * (lane + 64 * i)); } }
        for (int it = 0; it < 16; ++it) {
            const int tl = F.wid * 16 + it, tok = tokc + tl;
            f32x4 v[4]; float ss = 0.f;
#pragma unroll
            for (int i = 0; i < 4; ++i) { const u32x2 d2 = dn2[i]; v[i] = vn[i];
                v[i][0] += bflo(d2.x); v[i][1] += bfhi(d2.x); v[i][2] += bflo(d2.y); v[i][3] += bfhi(d2.y); ss += v[i][0] * v[i][0] + v[i][1] * v[i][1] + v[i][2] * v[i][2] + v[i][3] * v[i][3];
                u32x2 xw; xw.x = pk_bf16(v[i][0], v[i][1]); xw.y = pk_bf16(v[i][2], v[i][3]);
                *(u32x2*)((bf16_t*)dx + (size_t)tok * 1024 + 4 * (lane + 64 * i)) = xw; }
            { const int tokn = tokc + F.wid * 16 + ((it < 15) ? it + 1 : it);
#pragma unroll
              for (int i = 0; i < 4; ++i) { dn2[i] = *(const u32x2*)(dx + (size_t)tokn * 1024 + 4 * (lane + 64 * i)); vn[i] = *(const f32x4*)(x1 + (size_t)tokn * 1024 + 4 * (lane + 64 * i)); } }
            ss = wave_sum(ss);
            const float r = __builtin_amdgcn_rsqf(ss * (1.f / 1024.f) + EPS);
            float a[32];
#pragma unroll
            for (int e = 0; e < 32; ++e) a[e] = 0.f;
#pragma unroll
            for (int i = 0; i < 4; ++i) {
                f32x4 hn = v[i] * r * gf[i];
                *(unsigned*)(h2 + (size_t)tok * 1024 + 4 * (lane + 64 * i)) = pk4_fp8(hn[0] * SC_H2, hn[1] * SC_H2, hn[2] * SC_H2, hn[3] * SC_H2);
#pragma unroll
                for (int e = 0; e < 4; ++e) {
                    const LAS float* wr = W + (e * 256 + i * 64 + lane) * RT_PITCH;
#pragma unroll
                    for (int q = 0; q < 8; ++q) { const f32x4 wv = *(const LAS f32x4*)(wr + 4 * q);
#pragma unroll
                        for (int z = 0; z < 4; ++z) a[4 * q + z] += hn[e] * wv[z]; }
                }
            }
#define RT_STEP(mask, half) { const bool up = (lane & (mask)) != 0; _Pragma("unroll") for (int i = 0; i < (half); ++i) { const float keep = up ? a[i + (half)] : a[i], send = up ? a[i] : a[i + (half)]; a[i] = keep + __shfl_xor(send, (mask)); } }
            RT_STEP(32, 16) RT_STEP(16, 8) RT_STEP(8, 4) RT_STEP(4, 2) RT_STEP(2, 1)
#undef RT_STEP
            float val = a[0] + __shfl_xor(a[0], 1) + brt;
            float tv[4]; int te[4];
#pragma unroll
            for (int k = 0; k < 4; ++k) {
                float m = val;
#pragma unroll
                for (int d = 32; d >= 1; d >>= 1) m = fmaxf(m, __shfl_xor(m, d));
                const unsigned long long bal = __ballot(val == m);
                const int e = (__ffsll((long long)bal) - 1) >> 1;
                tv[k] = m; te[k] = e;
                if ((lane >> 1) == e) val = -INFINITY;
            }
            const float e1 = __expf(tv[1] - tv[0]), e2 = __expf(tv[2] - tv[0]), e3 = __expf(tv[3] - tv[0]);
            const float inv = 1.f / (1.f + e1 + e2 + e3);
            if (lane < 4) {
                const int ek = lane == 0 ? te[0] : (lane == 1 ? te[1] : (lane == 2 ? te[2] : te[3]));
                const float wk = (lane == 0 ? 1.f : (lane == 1 ? e1 : (lane == 2 ? e2 : e3))) * inv;
                const int slot = atomicAdd((int*)(lcount + ek), 1);
                rec_e[tl * 4 + lane] = ek; rec_s[tl * 4 + lane] = slot; rec_w[tl * 4 + lane] = wk;
            }
        }
        __syncthreads();
        if (F.tid < 32) lbase[F.tid] = atomicAdd(gcount + F.tid, lcount[F.tid]);
        __syncthreads();
        { const int idx = F.tid, e = rec_e[idx];
          list[e * LISTCAP + lbase[e] + rec_s[idx]] = tokc * 4 + idx; topw[tokc * 4 + idx] = rec_w[idx]; }
        __syncthreads();
    }
}

DI void moe_table(const Frame& F, LAS MoeTbl* tb) {
    const int* gcount = (const int*)(F.ws + WS_CTL + CW_CNT);
    if (F.tid < NE) tb->cnt[F.tid] = gcount[F.tid];
    __syncthreads();
    if (F.tid == 0) { int acc = 0; for (int e = 0; e < NE; ++e) { tb->rts[e] = acc; acc += (tb->cnt[e] + 255) >> 8; } tb->rts[NE] = acc; }
    __syncthreads();
}

DI void p10_final(const Frame& F) {
    const unsigned char* yk = F.ws + WS_DELTA; const float* topw = (const float*)(F.ws + WS_TOPW); float* out = F.out; const bf16_t* dx = (const bf16_t*)(F.ws + WS_PM);
    const int lane = F.lane;
    f32x4 gf[4];
#pragma unroll
    for (int i = 0; i < 4; ++i) gf[i] = *(const f32x4*)(F.in[I_GFIN] + 4 * (lane + 64 * i));
    for (int tok0 = (F.bid * 8 + F.wid) * 2; tok0 < T_; tok0 += F.G * 8 * 2) {
        f32x4 v[2][4]; unsigned y[2][4][4]; f32x4 tw[2];
#pragma unroll
        for (int r = 0; r < 2; ++r) { tw[r] = *(const f32x4*)(topw + (size_t)(tok0 + r) * 4) * (1.f / SC_Y);
#pragma unroll
            for (int i = 0; i < 4; ++i) { const u32x2 d2 = *(const u32x2*)(dx + (size_t)(tok0 + r) * 1024 + 4 * (lane + 64 * i));
                v[r][i] = (f32x4){bflo(d2.x), bfhi(d2.x), bflo(d2.y), bfhi(d2.y)}; }
#pragma unroll
            for (int k = 0; k < 4; ++k)
#pragma unroll
                for (int i = 0; i < 4; ++i) y[r][k][i] = *(const unsigned*)(yk + ((size_t)(tok0 + r) * 4 + k) * 1024 + 4 * (lane + 64 * i)); }
#pragma unroll
        for (int r = 0; r < 2; ++r) {
#pragma unroll
            for (int k = 0; k < 4; ++k)
#pragma unroll
                for (int i = 0; i < 4; ++i) { const f32x2 lo = __builtin_amdgcn_cvt_pk_f32_fp8(y[r][k][i], false), hi = __builtin_amdgcn_cvt_pk_f32_fp8(y[r][k][i], true);
                    v[r][i][0] += tw[r][k] * lo.x; v[r][i][1] += tw[r][k] * lo.y; v[r][i][2] += tw[r][k] * hi.x; v[r][i][3] += tw[r][k] * hi.y; }
            float ss = 0.f;
#pragma unroll
            for (int i = 0; i < 4; ++i) ss += v[r][i][0] * v[r][i][0] + v[r][i][1] * v[r][i][1] + v[r][i][2] * v[r][i][2] + v[r][i][3] * v[r][i][3];
            ss = wave_sum(ss);
            const float rn = __builtin_amdgcn_rsqf(ss * (1.f / 1024.f) + EPS);
#pragma unroll
            for (int i = 0; i < 4; ++i) *(f32x4*)(out + (size_t)(tok0 + r) * 1024 + 4 * (lane + 64 * i)) = v[r][i] * rn * gf[i];
        }
    }
}

__global__ void __launch_bounds__(512, 2) fwd(Params prm) {
    extern __shared__ __attribute__((aligned(16))) unsigned char lds_raw[];
#define T0() (wid_k == 0 && __builtin_amdgcn_mbcnt_hi(~0u, __builtin_amdgcn_mbcnt_lo(~0u, 0u)) == 0u)
#define FRAME() Frame F; F.lds = (LAS unsigned char*)lds_raw; { int t_ = wid_k * 64 + (int)__builtin_amdgcn_mbcnt_hi(~0u, __builtin_amdgcn_mbcnt_lo(~0u, 0u)); asm volatile("" : "+v"(t_)); F.tid = t_; } F.lane = F.tid & 63; F.wid = __builtin_amdgcn_readfirstlane(F.tid >> 6); \
    F.G = gridDim.x; F.bid = blockIdx.x; _Pragma("unroll") for (int i_ = 0; i_ < 20; ++i_) F.in[i_] = prm.in[i_]; F.out = prm.out; F.ws = prm.ws; unsigned char* ws = F.ws; (void)ws;
    LAS unsigned char* const ldsb = (LAS unsigned char*)lds_raw;
    const int wid_k = __builtin_amdgcn_readfirstlane(threadIdx.x >> 6);
    if (threadIdx.x == 0) *(LAS u32x4*)(ldsb + LDS_BARW) = (u32x4){0u, 0u, 0u, 0u};
    __syncthreads();
    XcdBarrier bar; bar.bar = (unsigned*)(prm.ws + WS_CTL + CW_BAR); bar.x = 0; bar.st = (volatile LAS unsigned*)(ldsb + LDS_BARW);
    if (N_LAUNCHES == 1) bar = xcd_barrier_post((unsigned*)(prm.ws + WS_CTL + CW_BAR), (volatile LAS unsigned*)(ldsb + LDS_BARW), T0());
    const int lo = prm.ph_lo, hi = prm.ph_hi;
#ifndef PHASE_MASK
#define PHASE_MASK 0x7ff
#endif
#define IN(k) (((PHASE_MASK >> (k)) & 1) && lo <= (k) && (k) < hi)
#define SEAM(k) do { if (IN(k) && IN((k) + 1)) xcd_barrier(bar, T0()); } while (0)
#ifndef REPEAT_MASK
#define REPEAT_MASK 0
#endif
#define REP(k) for (int rep_ = 0; rep_ < (((REPEAT_MASK >> (k)) & 1) ? 2 : 1); ++rep_)
    LAS MoeTbl* tb = (LAS MoeTbl*)(ldsb + pg8::STAGE_BYTES);

    REP(0) if (IN(0)) { if (rep_) xcd_barrier(bar, T0()); FRAME(); moe_weights(F, F.bid, F.G); p0_prologue(F); }
    SEAM(0);
    REP(1) if (IN(1)) { if (rep_) xcd_barrier(bar, T0());
        FRAME();
        DenseSched S; S.A = (const char*)(ws + WS_H); S.Bt = (const char*)(ws + WS_WIN); S.K = 1024; S.so.init(T_, NP, F.G, F.bid); S.mixgate = 1;
        EpiP E{(bf16_t*)(ws + WS_P)};
        pg8::gemm_phase(F.lds, F.tid, 1024, S, E);
    }
    SEAM(1);
    REP(2) if (IN(2)) { if (rep_) xcd_barrier(bar, T0());
        { FRAME(); pool_prep(F); }
        { FRAME();
          LAS unsigned char* wl = F.lds + F.wid * DW_BYTES;
          for (int u = F.bid * 8 + F.wid; u < 4096; u += F.G * 8) delta_prep_unit(F.ws, F.in[I_CONVW], F.in[I_ALOG], F.in[I_DTB], F.bid * 8 + F.wid, wl, u); }
    }
    SEAM(2);
    REP(3) if (IN(3)) { if (rep_) xcd_barrier(bar, T0()); FRAME(); delta_scan(F); }
    SEAM(3);
    REP(4) if (IN(4)) { if (rep_) xcd_barrier(bar, T0()); FRAME(); delta_out(F); }
    SEAM(4);
    REP(5) if (IN(5)) { if (rep_) xcd_barrier(bar, T0());
        FRAME();
        UpSched S; S.A0 = (const char*)(ws + WS_OA); S.A1 = (const char*)(ws + WS_PM); S.B0 = (const char*)(ws + WS_WA); S.B1 = (const char*)(ws + WS_WB); S.so.init(T_, 1024, F.G, F.bid);
        EpiUp E{(const bf16_t*)(ws + WS_P), (bf16_t*)(ws + WS_H)};
        pg8::gemm_phase(F.lds, F.tid, 512, S, E);
    }
    SEAM(5);
    REP(6) if (IN(6)) { if (rep_) xcd_barrier(bar, T0());
        FRAME();
        DenseSched S; S.A = (const char*)(ws + WS_H); S.Bt = (const char*)(ws + WS_WOUT); S.K = 1024; S.so.init(T_, 1024, F.G, F.bid); S.mixgate = 0;
        EpiStoreBf16 E{(bf16_t*)(ws + WS_PM), 1024};
        pg8::gemm_phase(F.lds, F.tid, 1024, S, E);
    }
    SEAM(6);
    REP(7) if (IN(7)) { if (rep_) xcd_barrier(bar, T0()); FRAME(); p7_router(F); }
    SEAM(7);
    REP(8) if (IN(8)) { if (rep_) xcd_barrier(bar, T0());
        FRAME();
        moe_table(F, tb);
        MoeSched S; S.A = (const char*)(ws + WS_H); S.Bt = (const char*)(ws + WS_WGU); S.list = (const int*)(ws + WS_LIST); S.tb = tb; S.K = 512; S.NT = 8; S.RG = 4; S.bid = F.bid;
        S.bstride = (size_t)2048 * 1024; S.gather = true;
        EpiGateUp E{ws + WS_P, F.in[I_BGU]};
        pg8::gemm_phase<EpiGateUp, MoeSched, true>(F.lds, F.tid, 512, S, E, E8_W, E8_H2);
    }
    SEAM(8);
    REP(9) if (IN(9)) { if (rep_) xcd_barrier(bar, T0());
        FRAME();
        moe_table(F, tb);
        MoeSched S; S.A = (const char*)(ws + WS_P); S.Bt = (const char*)(ws + WS_WD); S.list = (const int*)(ws + WS_LIST); S.tb = tb; S.K = 512; S.NT = 4; S.RG = 8; S.bid = F.bid;
        S.bstride = (size_t)1024 * 1024; S.gather = false;
        EpiDown E{ws + WS_DELTA, F.in[I_BD], (const int*)(ws + WS_LIST), tb};
        pg8::gemm_phase<EpiDown, MoeSched, true>(F.lds, F.tid, 512, S, E, E8_W, E8_ACT);
    }
    SEAM(9);
    REP(10) if (IN(10)) { if (rep_) xcd_barrier(bar, T0()); FRAME(); p10_final(F); }
#undef IN
#undef SEAM
}

extern "C" void kernel_launch(void* const* d_in, const int* in_sizes, int n_in, void* d_out, int out_size, void* d_ws, size_t ws_size, hipStream_t stream) {
    static int ready = 0;
    if (!ready) {
        if (n_in != 20 || out_size != T_ * D_ || ws_size < WS_END) { fprintf(stderr, "kernel_launch: unexpected shapes (n_in %d out %d ws %zu)\n", n_in, out_size, ws_size); ready = -1; return; }
        if (hipFuncSetAttribute((const void*)fwd, hipFuncAttributeMaxDynamicSharedMemorySize, LDS_BYTES) != hipSuccess) { fprintf(stderr, "kernel_launch: hipFuncSetAttribute failed\n"); ready = -1; return; }
        int per_cu = 0;
        if (hipOccupancyMaxActiveBlocksPerMultiprocessor(&per_cu, (const void*)fwd, 512, LDS_BYTES) != hipSuccess || per_cu < 1) fprintf(stderr, "kernel_launch: occupancy query says %d\n", per_cu);
        (void)hipGetLastError();
        ready = 1;
    }
    if (ready < 0) return;
    const int grid = 256;
    (void)hipMemsetAsync((char*)d_ws + WS_CTL, 0, CTL_BYTES, stream);
    Params p{};
    for (int i = 0; i < 20; ++i) p.in[i] = (const float*)d_in[i];
    p.out = (float*)d_out; p.ws = (unsigned char*)d_ws;
    if (N_LAUNCHES == 1) { p.ph_lo = 0; p.ph_hi = NPHASE; hipLaunchKernelGGL(fwd, dim3(grid), dim3(512), LDS_BYTES, stream, p); }
    else for (int k = 0; k < NPHASE; ++k) { p.ph_lo = k; p.ph_hi = k + 1; hipLaunchKernelGGL(fwd, dim3(grid), dim3(512), LDS_BYTES, stream, p); }
}
```

```cpp
#include <hip/hip_runtime.h>
#include <stdint.h>
#include <stdio.h>

#ifndef N_LAUNCHES
#define N_LAUNCHES 1
#endif

#define LAS __attribute__((address_space(3)))
typedef unsigned short bf16_t;
typedef short bf16x8 __attribute__((ext_vector_type(8)));
typedef float f32x4 __attribute__((ext_vector_type(4)));
typedef float f32x2 __attribute__((ext_vector_type(2)));
typedef unsigned u32x4 __attribute__((ext_vector_type(4)));
typedef unsigned u32x2 __attribute__((ext_vector_type(2)));
typedef __bf16 bfx2 __attribute__((ext_vector_type(2)));
#define DI __device__ __forceinline__

constexpr int T_ = 32768, D_ = 1024, L_ = 4096, NH = 8, NCH = 64;
constexpr int NP = 4608;
constexpr int PC_Q = 0, PC_K = 512, PC_V = 1024, PC_Z = 1536, PC_U = 2048, PC_GA = 2560, PC_GB = 3584;
constexpr int INW = 4624;
constexpr int NE = 32, LISTCAP = 32768;
constexpr int ACT_ROWS = 131072 + 8192;
constexpr float EPS = 1e-6f;
constexpr int NPHASE = 11;

constexpr size_t al256(size_t x) { return (x + 255) & ~(size_t)255; }
constexpr size_t WS_CTL = 0;
constexpr size_t CTL_BYTES = 65536;
constexpr size_t CW_BAR = 0;
constexpr size_t CW_CNT = 16384;
constexpr size_t WS_WIN = WS_CTL + CTL_BYTES;
constexpr size_t WS_WA = WS_WIN + (size_t)NP * 1024 * 2;
constexpr size_t WS_WB = WS_WA + (size_t)1024 * 512 * 2;
constexpr size_t WS_WOUT = WS_WB + (size_t)1024 * 512 * 2;
constexpr size_t WS_WGU = WS_WOUT + (size_t)1024 * 1024 * 2;
constexpr size_t WS_WD = WS_WGU + (size_t)NE * 2048 * 1024 * 2;
constexpr size_t WS_H = WS_WD + (size_t)NE * 1024 * 1024 * 2;
constexpr size_t WS_P = WS_H + (size_t)T_ * 1024 * 2;
constexpr size_t WS_DELTA = WS_P + (size_t)T_ * NP * 2;
DI int dl_cmajor(int unit) { return (unit & 63) * 64 + (unit >> 6); }
constexpr size_t DL_M = 0, DL_Q = (size_t)4096 * 8192, DL_S = 2 * DL_Q, DL_N = 3 * DL_Q, DL_O = DL_N + (size_t)4096 * 16384;
constexpr size_t WS_PM = WS_DELTA + (size_t)T_ * 4 * 1024 * 2;
constexpr size_t WS_OA = WS_PM + (size_t)T_ * 512 * 2;
constexpr size_t WS_TOPW = WS_OA + (size_t)T_ * 512 * 2;
constexpr size_t WS_LIST = WS_TOPW + (size_t)T_ * 4 * 4;
constexpr size_t WS_PARK = WS_LIST + (size_t)NE * LISTCAP * 4;
constexpr size_t WS_BA = WS_PARK + (size_t)2048 * 8192;
constexpr size_t WS_END = WS_BA + (size_t)T_ * 16 * 4;
static_assert(WS_END <= (size_t)1073741824, "workspace");
static_assert((size_t)ACT_ROWS * 1024 <= (size_t)T_ * NP * 2, "act (fp8) fits in p");

constexpr int LDS_BYTES = 163840;
constexpr int LDS_BARW = LDS_BYTES - 16;

DI unsigned pk_bf16(float lo, float hi) { bfx2 r = __builtin_convertvector((f32x2){lo, hi}, bfx2); return __builtin_bit_cast(unsigned, r); }
typedef int i32x8 __attribute__((ext_vector_type(8)));
typedef int i32x4 __attribute__((ext_vector_type(4)));
DI float clamp448(float x) { return fminf(fmaxf(x, -448.f), 448.f); }
DI unsigned pk4_fp8(float a, float b, float c, float d) {
    int w = 0; w = __builtin_amdgcn_cvt_pk_fp8_f32(clamp448(a), clamp448(b), w, false); w = __builtin_amdgcn_cvt_pk_fp8_f32(clamp448(c), clamp448(d), w, true); return (unsigned)w; }
constexpr float SC_H2 = 16.f, SC_ACT = 4.f, SC_W = 64.f, SC_Y = 16.f;
constexpr int E8_H2 = 0x7B7B7B7B, E8_ACT = 0x7D7D7D7D, E8_W = 0x79797979;
DI float bflo(unsigned u) { return __uint_as_float(u << 16); }
DI float bfhi(unsigned u) { return __uint_as_float(u & 0xffff0000u); }
DI float bf2f(unsigned short b) { return __uint_as_float(((unsigned)b) << 16); }
DI float fast_rcp(float x) { return __builtin_amdgcn_rcpf(x); }
DI float sigmoidf_(float x) { return fast_rcp(1.f + __expf(-x)); }
DI float siluf_(float x) { return x * sigmoidf_(x); }
DI float bperm(float v, int src_lane) { return __int_as_float(__builtin_amdgcn_ds_bpermute(src_lane << 2, __float_as_int(v))); }
DI void wsync() { asm volatile("s_waitcnt lgkmcnt(0)" ::: "memory"); }
DI float wave_sum(float v) {
#pragma unroll
    for (int m = 32; m >= 1; m >>= 1) v += __shfl_xor(v, m);
    return v;
}
DI bf16x8 mk8(u32x2 lo, u32x2 hi) { u32x4 v = {lo.x, lo.y, hi.x, hi.y}; return __builtin_bit_cast(bf16x8, v); }
DI bf16x8 pack2(f32x4 a, f32x4 b) { u32x4 v = {pk_bf16(a[0], a[1]), pk_bf16(a[2], a[3]), pk_bf16(b[0], b[1]), pk_bf16(b[2], b[3])}; return __builtin_bit_cast(bf16x8, v); }
DI f32x4 mfma16(bf16x8 a, bf16x8 b, f32x4 c) { return __builtin_amdgcn_mfma_f32_16x16x32_bf16(a, b, c, 0, 0, 0); }

#define XB_TMO      128
#define XB_XCNT(j)  (256  + 64 * (j))
#define XB_XSUB(j)  (1280 + 64 * (j))
#define XB_XGEN(j)  (2304 + 64 * (j))
#define XB_TOP      3328
#define XB_TOPGEN   3392
#define XCD_BAR_WORDS 3456
#define XB_SPIN_CAP (1u << 18)
DI unsigned xb_ld(unsigned* p)              { return __hip_atomic_load(p, __ATOMIC_RELAXED, __HIP_MEMORY_SCOPE_AGENT); }
DI unsigned xb_add(unsigned* p, unsigned v) { return __hip_atomic_fetch_add(p, v, __ATOMIC_RELAXED, __HIP_MEMORY_SCOPE_AGENT); }
DI unsigned xb_xcc_id() { return (unsigned)__builtin_amdgcn_s_getreg((3 << 11) | 20) & 0xFu; }
#define XB_SPIN(cond, bar) do { unsigned _sp = 0; while (cond) { __builtin_amdgcn_s_sleep(1); \
    if ((++_sp & 255u) == 0u) { if (xb_ld(&(bar)[XB_TMO])) break; if (_sp > XB_SPIN_CAP) { atomicAdd(&(bar)[XB_TMO], 1u); break; } } } } while (0)
struct XcdBarrier { unsigned* bar; unsigned x; volatile LAS unsigned* st; };
DI XcdBarrier xcd_barrier_post(unsigned* bar, volatile LAS unsigned* st, bool t0) {
    XcdBarrier b; b.bar = bar; b.x = xb_xcc_id(); b.st = st;
    if (t0) (void)xb_add(&bar[XB_XCNT(b.x)], 1u);
    return b;
}
DI void xcd_barrier_complete(unsigned* bar, unsigned x, unsigned& nloc, unsigned& nx) {
    const unsigned G = gridDim.x * gridDim.y * gridDim.z;
    unsigned sum, cnt, mine, sp = 0u;
    for (;;) {
        sum = 0u; cnt = 0u; mine = 0u;
#pragma unroll
        for (unsigned j = 0; j < 16; ++j) { const unsigned c = xb_ld(&bar[XB_XCNT(j)]); sum += c; cnt += (c > 0u) ? 1u : 0u; mine = (j == x) ? c : mine; }
        if (sum == G) break;
        __builtin_amdgcn_s_sleep(1);
        if ((++sp & 255u) == 0u) { if (xb_ld(&bar[XB_TMO])) break; if (sp > XB_SPIN_CAP) { atomicAdd(&bar[XB_TMO], 1u); break; } }
    }
    nloc = mine > 0u ? mine : 1u; nx = cnt > 0u ? cnt : 1u;
}
DI void xcd_barrier(const XcdBarrier& b, bool t0) {
    asm volatile("s_waitcnt vmcnt(0)" ::: "memory");
    __syncthreads();
    if (t0) {
        unsigned* bar = b.bar;
        __builtin_amdgcn_s_waitcnt(0);
        unsigned nloc = b.st[0], nx = b.st[1];
        if (nloc == 0u) { xcd_barrier_complete(bar, b.x, nloc, nx); b.st[0] = nloc; b.st[1] = nx; }
        const unsigned old = xb_add(&bar[XB_XSUB(b.x)], 1u);
        const unsigned gen = old / nloc;
        if (old + 1u == (gen + 1u) * nloc) {
            __builtin_amdgcn_fence(__ATOMIC_RELEASE, "agent");
            asm volatile("s_waitcnt vmcnt(0)" ::: "memory");
            const unsigned og = xb_add(&bar[XB_TOP], 1u);
            const unsigned tg = og / nx;
            if (og + 1u == (tg + 1u) * nx) xb_add(&bar[XB_TOPGEN], 1u);
            else XB_SPIN(xb_ld(&bar[XB_TOPGEN]) == tg, bar);
            __builtin_amdgcn_fence(__ATOMIC_ACQUIRE, "agent");
            xb_add(&bar[XB_XGEN(b.x)], 1u);
            asm volatile("s_waitcnt vmcnt(0)" ::: "memory");
        } else {
            XB_SPIN(xb_ld(&bar[XB_XGEN(b.x)]) == gen, bar);
            __builtin_amdgcn_fence(__ATOMIC_ACQUIRE, "agent");
            asm volatile("s_waitcnt vmcnt(0)" ::: "memory");
        }
    }
    __syncthreads();
}

namespace pg8 {
constexpr int BM = 256, BK = 64, HALF = 128, HTB = HALF * BK * 2, STAGE_BYTES = 8 * HTB, NXCD = 8, WGM = 8;
__host__ __device__ __forceinline__ int lds_byte(int r, int c) { const int st = (r >> 4) * 2 + (c >> 5), rr = r & 15, cc = c & 31, ob = rr * 64 + cc * 2; return st * 1024 + (ob ^ (((ob >> 9) & 1) << 5)); }
__host__ __device__ __forceinline__ void stage_rc(int b, int& R, int& C) { const int st = b / 1024, sb = b % 1024, swz = sb ^ (((sb >> 9) & 1) << 5); R = (st >> 1) * 16 + swz / 64; C = (st & 1) * 32 + (swz % 64) / 2; }
__host__ __device__ __forceinline__ int perm32(int rho) { const int n = rho >> 4, i = rho & 15; return 8 * (i >> 2) + 4 * n + (i & 3); }

struct Unit { int pm, pn, e; };

struct StaticOrder {
    int nM, nN, nwg, G, c;
    DI void init(int M, int N, int G_, int c_) { nM = M / BM; nN = N / BM; nwg = nM * nN; G = G_; c = c_; }
    DI bool next(int i, Unit& u) const {
        const long L = (long)i * G + c; if (L >= nwg) return false;
        int wgid = (int)L; { const int q = nwg / NXCD, r = nwg % NXCD, xcd = wgid % NXCD, off = wgid / NXCD; wgid = (xcd < r ? xcd * (q + 1) : r * (q + 1) + (xcd - r) * q) + off; }
        const int nig = WGM * nN, gid = wgid / nig, fm = gid * WGM, gsz = (nM - fm) < WGM ? (nM - fm) : WGM;
        u.pm = fm + ((wgid % nig) % gsz); u.pn = (wgid % nig) / gsz; u.e = 0; return true;
    }
};

template <bool FP8> struct FragT { typedef bf16x8 type; };
template <> struct FragT<true> { typedef i32x8 type; };
template <class Epi, class Sched, bool FP8 = false>
DI void gemm_phase(LAS unsigned char* lds, const int tid, const int K, const Sched& S, const Epi& E, const int sclW = 0, const int sclA = 0) {
    const int wid = __builtin_amdgcn_readfirstlane(tid >> 6), lane = tid & 63, wr = wid >> 2, wc = wid & 3, fr = lane & 15, fq = lane >> 4;
    const int nt = K / BK;
    int R0, C0; stage_rc(tid * 16, R0, C0);
    const int Rb0 = Epi::PERM ? ((R0 & ~31) + perm32(R0 & 31)) : R0;
    unsigned voffB[2]; voffB[0] = (unsigned)(Rb0 * K + C0) * 2u; voffB[1] = (unsigned)((Rb0 + 64) * K + C0) * 2u;
    const size_t kstep = (size_t)(BK * 2);
    const size_t hstep = (size_t)HALF * K * 2;
    const unsigned ldsw = (unsigned)wid * 1024u;
    const int aoff = lds_byte(wr * 64 + fr, fq * 8), boff = lds_byte(wc * 32 + fr, fq * 8);
#define PG8_SA(b, h) (((b) * 2 + (h)) * HTB)
#define PG8_SB(b, h) ((4 + (b) * 2 + (h)) * HTB)
#define PG8_STAGE(bufoff, gbase, voff) do { _Pragma("unroll") for (int _i = 0; _i < 2; ++_i) \
        __builtin_amdgcn_global_load_lds((const unsigned*)((const char*)(gbase) + (voff)[_i]), (LAS unsigned*)(lds + (bufoff) + ldsw + _i * 8192), 16, 0, 0); } while (0)
#define PG8_LD2(p) __builtin_shufflevector(*(const LAS i32x4*)(p), *(const LAS i32x4*)((p) + 1024), 0, 1, 2, 3, 4, 5, 6, 7)
#define PG8_LDA(dst, b, h) do { _Pragma("unroll") for (int m = 0; m < 4; ++m) { if constexpr (FP8) dst[m][0] = __builtin_bit_cast(frag_t, PG8_LD2(lds + PG8_SA(b, h) + aoff + m * 2048)); \
        else { _Pragma("unroll") for (int k = 0; k < 2; ++k) dst[m][k] = __builtin_bit_cast(frag_t, *(const LAS bf16x8*)(lds + PG8_SA(b, h) + aoff + m * 2048 + k * 1024)); } } } while (0)
#define PG8_LDB(dst, b, h) do { _Pragma("unroll") for (int n = 0; n < 2; ++n) { if constexpr (FP8) dst[n][0] = __builtin_bit_cast(frag_t, PG8_LD2(lds + PG8_SB(b, h) + boff + n * 2048)); \
        else { _Pragma("unroll") for (int k = 0; k < 2; ++k) dst[n][k] = __builtin_bit_cast(frag_t, *(const LAS bf16x8*)(lds + PG8_SB(b, h) + boff + n * 2048 + k * 1024)); } } } while (0)
#define PG8_MMA(ai, bj, At, Bt) do { __builtin_amdgcn_s_setprio(1); _Pragma("unroll") for (int m = 0; m < 4; ++m) _Pragma("unroll") for (int n = 0; n < 2; ++n) { \
        if constexpr (FP8) asm volatile("v_mfma_scale_f32_16x16x128_f8f6f4 %0, %1, %2, %0, %3, %4 op_sel_hi:[0,0,0]" : "+v"(acc[ai][bj][m][n]) : "v"(Bt[n][0]), "v"(At[m][0]), "v"(sclW), "v"(sclA)); \
        else { _Pragma("unroll") for (int k = 0; k < 2; ++k) acc[ai][bj][m][n] = __builtin_amdgcn_mfma_f32_16x16x32_bf16(__builtin_bit_cast(bf16x8, Bt[n][k]), __builtin_bit_cast(bf16x8, At[m][k]), acc[ai][bj][m][n], 0, 0, 0); } } \
        __builtin_amdgcn_s_setprio(0); } while (0)
#define PG8_WAIT_V(n) asm volatile("s_waitcnt vmcnt(" #n ")" ::: "memory")
#define PG8_WAIT_L(n) asm volatile("s_waitcnt lgkmcnt(" #n ")" ::: "memory")
#define PG8_BAR __builtin_amdgcn_s_barrier()
#define PG8_SCHED __builtin_amdgcn_sched_barrier(0)
    Unit cur, nxt; int ui = 0;
    if (!S.next(0, cur)) return;
    f32x4 acc[2][2][4][2];
#pragma unroll
    for (int a = 0; a < 2; ++a)
#pragma unroll
        for (int b = 0; b < 2; ++b)
#pragma unroll
            for (int m = 0; m < 4; ++m)
#pragma unroll
                for (int n = 0; n < 2; ++n) acc[a][b][m][n] = (f32x4){0.f, 0.f, 0.f, 0.f};
    typedef typename FragT<FP8>::type frag_t;
    frag_t At[4][FP8 ? 1 : 2], B0[2][FP8 ? 1 : 2], B1[2][FP8 ? 1 : 2];
    unsigned ca[2][2], na[2][2];
    S.a_offs(cur, R0, C0, ca);
    const char* cA = S.a_base(cur); const char* cB = S.b_tile(cur);
    PG8_STAGE(PG8_SB(0, 0), cB, voffB); PG8_STAGE(PG8_SB(0, 1), cB + hstep, voffB); PG8_STAGE(PG8_SA(0, 0), cA, ca[0]); PG8_STAGE(PG8_SA(0, 1), cA, ca[1]);
    if (wr == 1) PG8_BAR;
    PG8_WAIT_V(2); PG8_BAR;
    PG8_STAGE(PG8_SB(1, 0), cB + kstep, voffB); PG8_STAGE(PG8_SA(1, 0), cA + kstep, ca[0]); PG8_STAGE(PG8_SB(1, 1), cB + hstep + kstep, voffB);
    PG8_WAIT_V(6); PG8_BAR;
    for (;;) {
        const bool has_next = S.next(ui + 1, nxt);
        const char* nA = cA; const char* nB = cB;
#pragma unroll
        for (int h = 0; h < 2; ++h) { na[h][0] = ca[h][0]; na[h][1] = ca[h][1]; }
        if (has_next) { nA = S.a_base(nxt); nB = S.b_tile(nxt); S.a_offs(nxt, R0, C0, na); }
        for (int t = 0; t < nt; t += 2) {
            const bool last = (t == nt - 2);
            const char* a1 = cA + (size_t)(t + 1) * kstep;
            const char* a2 = last ? nA : cA + (size_t)(t + 2) * kstep; const char* b2 = last ? nB : cB + (size_t)(t + 2) * kstep;
            const char* a3 = a2 + kstep; const char* b3 = b2 + kstep;
            unsigned sa[2][2];
            if (last) {
#pragma unroll
                for (int h = 0; h < 2; ++h) { sa[h][0] = na[h][0]; sa[h][1] = na[h][1]; }
            } else {
#pragma unroll
                for (int h = 0; h < 2; ++h) { sa[h][0] = ca[h][0]; sa[h][1] = ca[h][1]; }
            }
            PG8_LDB(B0, 0, 0); PG8_LDB(B1, 0, 1); PG8_SCHED; PG8_LDA(At, 0, 0); PG8_STAGE(PG8_SA(1, 1), a1, ca[1]);
            PG8_WAIT_V(8); PG8_WAIT_L(0); PG8_BAR; PG8_MMA(0, 0, At, B0); PG8_MMA(0, 1, At, B1); PG8_BAR; PG8_SCHED;
            PG8_LDA(At, 0, 1); PG8_STAGE(PG8_SB(0, 0), b2, voffB); PG8_STAGE(PG8_SB(0, 1), b2 + hstep, voffB); PG8_STAGE(PG8_SA(0, 0), a2, sa[0]);
            PG8_WAIT_V(8); PG8_WAIT_L(0); PG8_BAR; PG8_MMA(1, 0, At, B0); PG8_MMA(1, 1, At, B1); PG8_BAR; PG8_SCHED;
            PG8_LDB(B0, 1, 0); PG8_LDB(B1, 1, 1); PG8_SCHED; PG8_LDA(At, 1, 0); PG8_STAGE(PG8_SA(0, 1), a2, sa[1]);
            PG8_WAIT_V(8); PG8_WAIT_L(0); PG8_BAR; PG8_MMA(0, 0, At, B0); PG8_MMA(0, 1, At, B1); PG8_BAR; PG8_SCHED;
            PG8_LDA(At, 1, 1); PG8_STAGE(PG8_SB(1, 0), b3, voffB); PG8_STAGE(PG8_SB(1, 1), b3 + hstep, voffB); PG8_STAGE(PG8_SA(1, 0), a3, sa[0]);
            PG8_WAIT_V(8); PG8_WAIT_L(0); PG8_BAR; PG8_MMA(1, 0, At, B0); PG8_MMA(1, 1, At, B1); PG8_BAR; PG8_SCHED;
        }
        if constexpr (FP8) asm volatile("s_nop 15\n\ts_nop 15" ::: "memory");
        if (wr == 0) PG8_BAR;
        const bool keep = E(acc, cur, wr, wc, fr, fq);
        if (!has_next) break;
        if (!keep) {
#pragma unroll
            for (int a = 0; a < 2; ++a)
#pragma unroll
                for (int b = 0; b < 2; ++b)
#pragma unroll
                    for (int m = 0; m < 4; ++m)
#pragma unroll
                        for (int n = 0; n < 2; ++n) acc[a][b][m][n] = (f32x4){0.f, 0.f, 0.f, 0.f};
        }
        cur = nxt; cA = nA; cB = nB; ++ui;
#pragma unroll
        for (int h = 0; h < 2; ++h) { ca[h][0] = na[h][0]; ca[h][1] = na[h][1]; }
        if (wr == 1) PG8_BAR;
    }
    PG8_WAIT_V(0);
    PG8_BAR;
#undef PG8_SA
#undef PG8_SB
#undef PG8_STAGE
#undef PG8_LDA
#undef PG8_LDB
#undef PG8_MMA
#undef PG8_LD2
#undef PG8_WAIT_V
#undef PG8_WAIT_L
#undef PG8_BAR
#undef PG8_SCHED
}
}
using pg8::Unit;

struct Params { const float* in[20]; float* out; unsigned char* ws; int ph_lo, ph_hi; };
enum { I_X = 0, I_GMIX, I_WIN, I_CONVW, I_ALOG, I_DTB, I_DNN, I_WUPA, I_POOLW, I_POOLS, I_WUPB, I_WOUT, I_GFFN, I_WR, I_BR, I_WGU, I_BGU, I_WD, I_BD, I_GFIN };

struct Frame {
    LAS unsigned char* lds; int tid, lane, wid, G, bid;
    const float* in[20]; float* out; unsigned char* ws;
};

struct DenseSched {
    const char* A; const char* Bt; int K; pg8::StaticOrder so; int mixgate;
    DI bool next(int i, Unit& u) const { const bool ok = so.next(i, u); if (mixgate) { const int s = u.pn; u.pn = s >= 16 ? s - 8 : ((s & 1) ? 10 + (s >> 1) : (s >> 1)); } return ok; }
    DI const char* a_base(const Unit&) const { return A; }
    DI const char* b_tile(const Unit& u) const { return Bt + (size_t)u.pn * 256 * K * 2; }
    DI void a_offs(const Unit& u, int R0, int C0, unsigned (&o)[2][2]) const {
#pragma unroll
        for (int h = 0; h < 2; ++h)
#pragma unroll
            for (int i = 0; i < 2; ++i) o[h][i] = (unsigned)((u.pm * 256 + h * 128 + R0 + 64 * i) * K + C0) * 2u;
    }
};
struct UpSched {
    const char* A0; const char* A1; const char* B0; const char* B1; pg8::StaticOrder so;
    DI bool next(int i, Unit& u) const { const bool ok = so.next(i >> 1, u); u.e = i & 1; return ok; }
    DI const char* a_base(const Unit& u) const { return u.e ? A1 : A0; }
    DI const char* b_tile(const Unit& u) const { return (u.e ? B1 : B0) + (size_t)u.pn * 256 * 512 * 2; }
    DI void a_offs(const Unit& u, int R0, int C0, unsigned (&o)[2][2]) const {
#pragma unroll
        for (int h = 0; h < 2; ++h)
#pragma unroll
            for (int i = 0; i < 2; ++i) o[h][i] = (unsigned)((u.pm * 256 + h * 128 + R0 + 64 * i) * 512 + C0) * 2u;
    }
};
struct MoeTbl { int rts[NE + 1]; int cnt[NE]; };
struct MoeSched {
    const char* A; const char* Bt; const int* list; const LAS MoeTbl* tb; int K, NT  , RG  , bid; size_t bstride; bool gather;
    DI bool next(int i, Unit& u) const {
        const int xcd = bid & 7, j = bid >> 3;
        const int rt = RG * (i * 8 + xcd) + j / NT;
        if (rt >= tb->rts[NE]) return false;
        int e = 0;
        for (int q = 1; q < NE; ++q) e += (tb->rts[q] <= rt) ? 1 : 0;
        u.pm = rt; u.pn = j % NT; u.e = e; return true;
    }
    DI const char* a_base(const Unit&) const { return A; }
    DI const char* b_tile(const Unit& u) const { return Bt + (size_t)u.e * bstride + (size_t)u.pn * 256 * K * 2; }
    DI void a_offs(const Unit& u, int R0, int C0, unsigned (&o)[2][2]) const {
        const int lr0 = (u.pm - tb->rts[u.e]) * 256, cnt = tb->cnt[u.e];
#pragma unroll
        for (int h = 0; h < 2; ++h)
#pragma unroll
            for (int i = 0; i < 2; ++i) {
                const int r = h * 128 + R0 + 64 * i;
                int row;
                if (gather) { const int idx = lr0 + r; row = list[u.e * LISTCAP + (idx < cnt ? idx : cnt - 1)] >> 2; }
                else row = u.pm * 256 + r;
                o[h][i] = (unsigned)(row * K + C0) * 2u;
            }
    }
};

template <int K> DI float ubf(unsigned w) { float r; if (K == 0) asm("v_cvt_f32_ubyte0 %0, %1" : "=v"(r) : "v"(w)); else if (K == 1) asm("v_cvt_f32_ubyte1 %0, %1" : "=v"(r) : "v"(w)); else if (K == 2) asm("v_cvt_f32_ubyte2 %0, %1" : "=v"(r) : "v"(w)); else asm("v_cvt_f32_ubyte3 %0, %1" : "=v"(r) : "v"(w)); return r; }
struct EpiStoreBf16 {
    static constexpr bool PERM = true;
    bf16_t* O; int ldc;
    DI bool operator()(f32x4 (&acc)[2][2][4][2], const Unit& u, int wr, int wc, int fr, int fq) const {
        const int row0 = u.pm * 256 + wr * 64 + fr, col0 = u.pn * 256 + wc * 32 + 8 * fq;
#pragma unroll
        for (int ai = 0; ai < 2; ++ai)
#pragma unroll
            for (int m = 0; m < 4; ++m) { bf16_t* rowp = O + (size_t)(row0 + ai * 128 + m * 16) * ldc + col0;
#pragma unroll
                for (int bj = 0; bj < 2; ++bj) { const f32x4 v0 = acc[ai][bj][m][0], v1 = acc[ai][bj][m][1];
                    u32x4 w; w.x = pk_bf16(v0[0], v0[1]); w.y = pk_bf16(v0[2], v0[3]); w.z = pk_bf16(v1[0], v1[1]); w.w = pk_bf16(v1[2], v1[3]);
                    *(u32x4*)(rowp + bj * 128) = w; } }
        return false;
    }
};
struct EpiP {
    static constexpr bool PERM = true;
    bf16_t* O;
    DI bool operator()(f32x4 (&acc)[2][2][4][2], const Unit& u, int wr, int wc, int fr, int fq) const {
        const int row0 = u.pm * 256 + wr * 64 + fr;
        const bool gate = u.pn >= 10;
        const int colA = gate ? PC_GA + (u.pn - 10) * 128 + wc * 32 + 8 * fq : u.pn * 256 + wc * 32 + 8 * fq;
        const int colB = gate ? PC_GB + (u.pn - 10) * 128 + wc * 32 + 8 * fq : colA + 128;
#pragma unroll
        for (int ai = 0; ai < 2; ++ai)
#pragma unroll
            for (int m = 0; m < 4; ++m) { bf16_t* rowp = O + (size_t)(row0 + ai * 128 + m * 16) * NP;
                float a[8], b[8];
#pragma unroll
                for (int j = 0; j < 8; ++j) { a[j] = acc[ai][0][m][j >> 2][j & 3]; b[j] = acc[ai][1][m][j >> 2][j & 3]; }
                if (gate) {
                    u32x4 w = {0u, 0u, 0u, 0u};
#pragma unroll
                    for (int j = 0; j < 8; ++j) { const float sa = fast_rcp(1.f + __expf(-a[j])), sb = fast_rcp(1.f + __expf(-b[j]));
                        const float qa = __builtin_rintf(sa * 255.f), qb = fmaxf(__builtin_rintf(sb * 255.f), 1.f);
                        if (j < 4) { w.x = __builtin_amdgcn_cvt_pk_u8_f32(qa, j & 3, w.x); w.z = __builtin_amdgcn_cvt_pk_u8_f32(qb, j & 3, w.z); }
                        else { w.y = __builtin_amdgcn_cvt_pk_u8_f32(qa, j & 3, w.y); w.w = __builtin_amdgcn_cvt_pk_u8_f32(qb, j & 3, w.w); } }
                    __builtin_nontemporal_store(w, (u32x4*)((unsigned char*)rowp + PC_GA * 2 + (((u.pn - 10) * 16 + wc * 4 + fq) * 16)));
                    continue;
                }
                u32x4 w; w.x = pk_bf16(a[0], a[1]); w.y = pk_bf16(a[2], a[3]); w.z = pk_bf16(a[4], a[5]); w.w = pk_bf16(a[6], a[7]);
                __builtin_nontemporal_store(w, (u32x4*)(rowp + colA));
                w.x = pk_bf16(b[0], b[1]); w.y = pk_bf16(b[2], b[3]); w.z = pk_bf16(b[4], b[5]); w.w = pk_bf16(b[6], b[7]);
                __builtin_nontemporal_store(w, (u32x4*)(rowp + colB)); }
        return false;
    }
};
struct EpiUp {
    static constexpr bool PERM = true;
    const bf16_t* P; bf16_t* O;
    DI bool operator()(f32x4 (&acc)[2][2][4][2], const Unit& u, int wr, int wc, int fr, int fq) const {
        const int row0 = u.pm * 256 + wr * 64 + fr, col0 = u.pn * 256 + wc * 32 + 8 * fq;
        const unsigned char* G = (const unsigned char*)P + PC_GA * 2 + (u.pn * 32 + wc * 4 + fq) * 16;
#pragma unroll
        for (int ai = 0; ai < 2; ++ai) {
            u32x4 gv[4][2];
#pragma unroll
            for (int m = 0; m < 4; ++m)
#pragma unroll
                for (int bj = 0; bj < 2; ++bj) gv[m][bj] = *(const u32x4*)(G + (size_t)(row0 + ai * 128 + m * 16) * (NP * 2) + bj * 256);
#pragma unroll
            for (int m = 0; m < 4; ++m) { const size_t row = (size_t)(row0 + ai * 128 + m * 16);
#pragma unroll
                for (int bj = 0; bj < 2; ++bj) {
                    const u32x4 g4 = gv[m][bj];
                    const float qb8[8] = {ubf<0>(g4.z), ubf<1>(g4.z), ubf<2>(g4.z), ubf<3>(g4.z), ubf<0>(g4.w), ubf<1>(g4.w), ubf<2>(g4.w), ubf<3>(g4.w)};
                    if (u.e == 0) {
                        const float qa8[8] = {ubf<0>(g4.x), ubf<1>(g4.x), ubf<2>(g4.x), ubf<3>(g4.x), ubf<0>(g4.y), ubf<1>(g4.y), ubf<2>(g4.y), ubf<3>(g4.y)};
#pragma unroll
                        for (int j = 0; j < 8; ++j) acc[ai][bj][m][j >> 2][j & 3] *= qa8[j] * fast_rcp(qb8[j]);
                    } else {
                        float o[8];
#pragma unroll
                        for (int j = 0; j < 8; ++j) o[j] = acc[ai][bj][m][j >> 2][j & 3] * (qb8[j] * (1.f / 255.f));
                        u32x4 w; w.x = pk_bf16(o[0], o[1]); w.y = pk_bf16(o[2], o[3]); w.z = pk_bf16(o[4], o[5]); w.w = pk_bf16(o[6], o[7]);
                        *(u32x4*)(O + row * 1024 + col0 + bj * 128) = w;
                    } } }
            asm volatile("" ::: "memory");
        }
        return u.e == 0;
    }
};
struct EpiResid {
    static constexpr bool PERM = false;
    const float* X; float* O;
    DI bool operator()(f32x4 (&acc)[2][2][4][2], const Unit& u, int wr, int wc, int fr, int fq) const {
        const int row0 = u.pm * 256 + wr * 64 + fr, col0 = u.pn * 256 + wc * 32 + 4 * fq;
#pragma unroll
        for (int ai = 0; ai < 2; ++ai)
#pragma unroll
            for (int m = 0; m < 4; ++m) { const size_t ro = (size_t)(row0 + ai * 128 + m * 16) * 1024 + col0;
#pragma unroll
                for (int bj = 0; bj < 2; ++bj)
#pragma unroll
                    for (int n = 0; n < 2; ++n) { const f32x4 xv = *(const f32x4*)(X + ro + bj * 128 + n * 16); *(f32x4*)(O + ro + bj * 128 + n * 16) = acc[ai][bj][m][n] + xv; } }
        return false;
    }
};
struct EpiGateUp {
    static constexpr bool PERM = true;
    unsigned char* ACT; const float* bgu;
    DI bool operator()(f32x4 (&acc)[2][2][4][2], const Unit& u, int wr, int wc, int fr, int fq) const {
        const int row0 = u.pm * 256 + wr * 64 + fr, c0 = u.pn * 128 + wc * 32 + 8 * fq;
        const float* bg = bgu + (size_t)u.e * 2048 + c0;
        f32x2 bgv[4], buv[4];
#pragma unroll
        for (int q = 0; q < 4; ++q) { bgv[q] = *(const f32x2*)(bg + 2 * q); buv[q] = *(const f32x2*)(bg + 1024 + 2 * q); }
#pragma unroll
        for (int ai = 0; ai < 2; ++ai)
#pragma unroll
            for (int m = 0; m < 4; ++m) {
                f32x2 o[4];
#pragma unroll
                for (int q = 0; q < 4; ++q) {
                    f32x2 gt = (f32x2){acc[ai][0][m][q >> 1][2 * (q & 1)], acc[ai][0][m][q >> 1][2 * (q & 1) + 1]} + bgv[q];
                    f32x2 up = (f32x2){acc[ai][1][m][q >> 1][2 * (q & 1)], acc[ai][1][m][q >> 1][2 * (q & 1) + 1]} + buv[q];
                    gt.x = fminf(gt.x, 7.f); gt.y = fminf(gt.y, 7.f);
                    up.x = __builtin_amdgcn_fmed3f(up.x, -7.f, 7.f); up.y = __builtin_amdgcn_fmed3f(up.y, -7.f, 7.f);
                    const f32x2 ex = gt * (-1.702f * 1.44269504f);
                    f32x2 den; den.x = __builtin_amdgcn_exp2f(ex.x); den.y = __builtin_amdgcn_exp2f(ex.y);
                    den = den + 1.f;
                    f32x2 sg; sg.x = fast_rcp(den.x); sg.y = fast_rcp(den.y);
                    o[q] = (gt * sg) * (up * SC_ACT + SC_ACT);
                }
                u32x2 w;
                { int t = 0; t = __builtin_amdgcn_cvt_pk_fp8_f32(o[0].x, o[0].y, t, false); t = __builtin_amdgcn_cvt_pk_fp8_f32(o[1].x, o[1].y, t, true); w.x = (unsigned)t; }
                { int t = 0; t = __builtin_amdgcn_cvt_pk_fp8_f32(o[2].x, o[2].y, t, false); t = __builtin_amdgcn_cvt_pk_fp8_f32(o[3].x, o[3].y, t, true); w.y = (unsigned)t; }
                *(u32x2*)(ACT + (size_t)(row0 + ai * 128 + m * 16) * 1024 + c0) = w;
            }
        return false;
    }
};
struct EpiDown {
    static constexpr bool PERM = true;
    unsigned char* YK; const float* bd; const int* list; const LAS MoeTbl* tb;
    DI bool operator()(f32x4 (&acc)[2][2][4][2], const Unit& u, int wr, int wc, int fr, int fq) const {
        const int lr0 = (u.pm - tb->rts[u.e]) * 256 + wr * 64 + fr, cnt = tb->cnt[u.e], col0 = u.pn * 256 + wc * 32 + 8 * fq;
        const float* b = bd + (size_t)u.e * 1024 + col0;
        f32x4 bv[2][2];
#pragma unroll
        for (int bj = 0; bj < 2; ++bj) { bv[bj][0] = *(const f32x4*)(b + bj * 128); bv[bj][1] = *(const f32x4*)(b + bj * 128 + 4); }
        int dst[2][4];
#pragma unroll
        for (int ai = 0; ai < 2; ++ai)
#pragma unroll
            for (int m = 0; m < 4; ++m) { const int idx = lr0 + ai * 128 + m * 16; const int d = list[u.e * LISTCAP + (idx < cnt ? idx : cnt - 1)]; dst[ai][m] = (idx < cnt) ? d : 4 * T_; }
#pragma unroll
        for (int ai = 0; ai < 2; ++ai)
#pragma unroll
            for (int m = 0; m < 4; ++m) {
                unsigned char* rowp = YK + (size_t)dst[ai][m] * 1024 + col0;
#pragma unroll
                for (int bj = 0; bj < 2; ++bj) { const f32x4 v0 = (acc[ai][bj][m][0] + bv[bj][0]) * SC_Y, v1 = (acc[ai][bj][m][1] + bv[bj][1]) * SC_Y;
                    u32x2 w; w.x = pk4_fp8(v0[0], v0[1], v0[2], v0[3]); w.y = pk4_fp8(v1[0], v1[1], v1[2], v1[3]);
                    *(u32x2*)(rowp + bj * 128) = w; }
            }
        return false;
    }
};

template <class CM>
DI void transpose_tile(const Frame& F, const float* src, int ldsrc, bf16_t* dst, int K, int k0, int n0, CM cm) {
    LAS float* tile = (LAS float*)F.lds;
    const int r = F.tid >> 4, c4 = (F.tid & 15) * 4;
    const int col0 = cm(n0 + c4);
#pragma unroll
    for (int pass = 0; pass < 2; ++pass) {
        const int rr = r + 32 * pass;
        f32x4 v = {0.f, 0.f, 0.f, 0.f};
        if (col0 >= 0) v = *(const f32x4*)(src + (size_t)(k0 + rr) * ldsrc + col0);
#pragma unroll
        for (int e = 0; e < 4; ++e) tile[rr * 65 + c4 + e] = v[e];
    }
    __syncthreads();
    const int n = F.tid >> 3, k8 = (F.tid & 7) * 8;
    float x[8];
#pragma unroll
    for (int e = 0; e < 8; ++e) x[e] = tile[(k8 + e) * 65 + n];
    u32x4 w; w.x = pk_bf16(x[0], x[1]); w.y = pk_bf16(x[2], x[3]); w.z = pk_bf16(x[4], x[5]); w.w = pk_bf16(x[6], x[7]);
    *(u32x4*)(dst + (size_t)(n0 + n) * K + k0 + k8) = w;
    __syncthreads();
}
struct BigTile { const float* src; unsigned char* dst; int ldsrc, k0, n0, scol, dpitch, bf; };
DI int cm_win(int n) { if (n < 2560) return n < 2048 ? n : n + 16; const int t = (n - 2560) >> 8, j = (n - 2560) & 255; return j < 128 ? 2576 + 128 * t + j : 3600 + 128 * t + (j - 128); }
DI void bt_load(const BigTile& t, int tid, f32x4 (&v)[8]) {
    const int r = tid >> 5, c4 = (tid & 31) * 4;
#pragma unroll
    for (int p = 0; p < 8; ++p) v[p] = *(const f32x4*)(t.src + (size_t)(t.k0 + r + 16 * p) * t.ldsrc + t.scol + c4);
}
DI void bt_store(const BigTile& t, LAS float* tile  , int tid, const f32x4 (&v)[8]) {
    const int r = tid >> 5, c4 = (tid & 31) * 4;
#pragma unroll
    for (int p = 0; p < 8; ++p) *(LAS f32x4*)(tile + (r + 16 * p) * 132 + c4) = v[p];
    __syncthreads();
    const int n = tid >> 2, kq = (tid & 3) * 32;
    float x[32];
#pragma unroll
    for (int e = 0; e < 32; ++e) x[e] = tile[(kq + e) * 132 + n];
    if (t.bf) {
        bf16_t* o = (bf16_t*)t.dst + (size_t)(t.n0 + n) * t.dpitch + t.k0 + kq;
#pragma unroll
        for (int q = 0; q < 4; ++q) { u32x4 w; w.x = pk_bf16(x[8 * q], x[8 * q + 1]); w.y = pk_bf16(x[8 * q + 2], x[8 * q + 3]); w.z = pk_bf16(x[8 * q + 4], x[8 * q + 5]); w.w = pk_bf16(x[8 * q + 6], x[8 * q + 7]);
            *(u32x4*)(o + 8 * q) = w; }
    } else {
        unsigned char* o = t.dst + (size_t)(t.n0 + n) * t.dpitch + t.k0 + kq;
#pragma unroll
        for (int q = 0; q < 2; ++q) { u32x4 w;
            w.x = pk4_fp8(x[16 * q] * SC_W, x[16 * q + 1] * SC_W, x[16 * q + 2] * SC_W, x[16 * q + 3] * SC_W); w.y = pk4_fp8(x[16 * q + 4] * SC_W, x[16 * q + 5] * SC_W, x[16 * q + 6] * SC_W, x[16 * q + 7] * SC_W);
            w.z = pk4_fp8(x[16 * q + 8] * SC_W, x[16 * q + 9] * SC_W, x[16 * q + 10] * SC_W, x[16 * q + 11] * SC_W); w.w = pk4_fp8(x[16 * q + 12] * SC_W, x[16 * q + 13] * SC_W, x[16 * q + 14] * SC_W, x[16 * q + 15] * SC_W);
            *(u32x4*)(o + 16 * q) = w; }
    }
    __syncthreads();
}
constexpr int NWT = 4096 + 2048 + 288 + 64 + 32;
DI BigTile moe_w_tile(const Frame& F, int i) {
    BigTile t; t.bf = 0; t.dpitch = 1024;
    if (i < 4096) { const int e = i >> 7, r = i & 127, nb = r >> 3; t.src = F.in[I_WGU] + (size_t)e * 1024 * 2048; t.dst = F.ws + WS_WGU + (size_t)e * 2048 * 1024; t.ldsrc = 2048; t.k0 = (r & 7) * 128; t.n0 = nb * 128;
        t.scol = (nb & 1) ? 1024 + (nb >> 1) * 128 : (nb >> 1) * 128; }
    else if (i < 6144) { const int j = i - 4096, e = j >> 6, r = j & 63; t.src = F.in[I_WD] + (size_t)e * 1024 * 1024; t.dst = F.ws + WS_WD + (size_t)e * 1024 * 1024; t.ldsrc = 1024; t.k0 = (r & 7) * 128; t.n0 = (r >> 3) * 128; t.scol = t.n0; }
    else if (i < 6432) { const int j = i - 6144; t.bf = 1; t.src = F.in[I_WIN]; t.dst = F.ws + WS_WIN; t.ldsrc = INW; t.k0 = (j & 7) * 128; t.n0 = (j >> 3) * 128; t.scol = cm_win(t.n0); }
    else if (i < 6496) { const int j = i - 6432; t.bf = 1; t.src = F.in[I_WOUT]; t.dst = F.ws + WS_WOUT; t.ldsrc = 1024; t.k0 = (j & 7) * 128; t.n0 = (j >> 3) * 128; t.scol = t.n0; }
    else { const int j = i - 6496; t.bf = 1; t.dpitch = 512; t.src = F.in[I_WUPA]; t.dst = F.ws + WS_WA; t.ldsrc = 1024; t.k0 = (j & 3) * 128; t.n0 = (j >> 2) * 128; t.scol = t.n0; }
    return t;
}
DI void moe_weights(const Frame& F, int rank, int nrank) {
    LAS float* tile = (LAS float*)F.lds;
    const int per = (NWT + nrank - 1) / nrank;
    f32x4 v[3][8];
#define MW_TILE(j) moe_w_tile(F, min(rank + (j) * nrank, NWT - 1))
    { const BigTile t0 = MW_TILE(0); bt_load(t0, F.tid, v[0]); const BigTile t1 = MW_TILE(1); bt_load(t1, F.tid, v[1]); const BigTile t2 = MW_TILE(2); bt_load(t2, F.tid, v[2]); }
    for (int j0 = 0; j0 < per; j0 += 3) {
#pragma unroll
        for (int q = 0; q < 3; ++q) {
            const BigTile t = MW_TILE(j0 + q);
            bt_store(t, tile, F.tid, v[q]);
            const BigTile tn = MW_TILE(j0 + q + 3);
            bt_load(tn, F.tid, v[q]);
        }
    }
#undef MW_TILE
}
struct CmIdent { DI int operator()(int n) const { return n; } };
struct CmWin { DI int operator()(int n) const { if (n < 2560) return n < 2048 ? n : n + 16; const int t = (n - 2560) >> 8, j = (n - 2560) & 255; return j < 128 ? 2576 + 128 * t + j : 3600 + 128 * t + (j - 128); } };
struct CmGu { DI int operator()(int n) const { const int pn = n >> 8, j = n & 255; return j < 128 ? pn * 128 + j : 1024 + pn * 128 + (j - 128); } };

DI void p0_prologue(const Frame& F) {
    unsigned char* ws = F.ws;
    {
        LAS float* Bs = (LAS float*)F.lds;
        LAS float* Ps = Bs + 128 * 64;
        bf16_t* d = (bf16_t*)(ws + WS_WB);
        for (int u = F.bid; u < 4 * 16 * 4; u += F.G) {
            const int g = u >> 6, n0 = ((u >> 2) & 15) * 64, c0 = (u & 3) * 32;
            for (int i = F.tid; i < 128 * 16; i += 512) { const int dd = i >> 4, q = i & 15;
                const f32x4 w = *(const f32x4*)(F.in[I_WUPB] + (size_t)(g * 128 + dd) * 1024 + n0 + 4 * q); const float sc = F.in[I_POOLS][g * 128 + dd];
                *(LAS f32x4*)(Bs + dd * 64 + 4 * q) = w * sc; }
            for (int i = F.tid; i < 32 * 32; i += 512) { const int c = i >> 5, q = i & 31;
                *(LAS f32x4*)(Ps + c * 128 + 4 * q) = *(const f32x4*)(F.in[I_POOLW] + (size_t)g * 128 * 128 + (size_t)(c0 + c) * 128 + 4 * q); }
            __syncthreads();
            const int n = F.lane, cw = F.wid * 4;
            float acc[4] = {0.f, 0.f, 0.f, 0.f};
            for (int dd = 0; dd < 128; dd += 4) {
                const float b0 = Bs[dd * 64 + n], b1 = Bs[(dd + 1) * 64 + n], b2 = Bs[(dd + 2) * 64 + n], b3 = Bs[(dd + 3) * 64 + n];
#pragma unroll
                for (int c = 0; c < 4; ++c) { const f32x4 p = *(const LAS f32x4*)(Ps + (cw + c) * 128 + dd); acc[c] += p[0] * b0 + p[1] * b1 + p[2] * b2 + p[3] * b3; }
            }
            u32x2 w; w.x = pk_bf16(acc[0], acc[1]); w.y = pk_bf16(acc[2], acc[3]);
            *(u32x2*)(d + (size_t)(n0 + n) * 512 + g * 128 + c0 + cw) = w;
            __syncthreads();
        }
    }
    {
        const float* x = F.in[I_X]; const float* gm = F.in[I_GMIX]; bf16_t* hb = (bf16_t*)(ws + WS_H); float* BA = (float*)(ws + WS_BA);
        LAS float* W16 = (LAS float*)F.lds;
        __syncthreads();
        for (int i = F.tid; i < 1024 * 4; i += 512) { const int k = i >> 2, q = i & 3;
            *(LAS f32x4*)(W16 + ((k & 3) * 256 + (k >> 2)) * 20 + 4 * q) = *(const f32x4*)(F.in[I_WIN] + (size_t)k * INW + 2048 + 4 * q); }
        __syncthreads();
        f32x4 g[4];
#pragma unroll
        for (int i = 0; i < 4; ++i) g[i] = *(const f32x4*)(gm + 4 * (F.lane + 64 * i));
        const int lane = F.lane;
        f32x4 vn[4][4];
#define RMS_LOAD(t0) do { _Pragma("unroll") for (int r = 0; r < 4; ++r) { const f32x4* xr = (const f32x4*)(x + (size_t)((t0) + r) * 1024); \
            _Pragma("unroll") for (int i = 0; i < 4; ++i) vn[r][i] = xr[lane + 64 * i]; } } while (0)
        RMS_LOAD((F.bid * 8 + F.wid) * 4);
        for (int tok0 = (F.bid * 8 + F.wid) * 4; tok0 < T_; tok0 += F.G * 8 * 4) {
            f32x4 v[4][4]; float rn[4];
#pragma unroll
            for (int r = 0; r < 4; ++r)
#pragma unroll
                for (int i = 0; i < 4; ++i) v[r][i] = vn[r][i];
            { const int tn = tok0 + F.G * 8 * 4; RMS_LOAD(tn < T_ ? tn : tok0); }
#pragma unroll
            for (int r = 0; r < 4; ++r) { float a = 0.f;
#pragma unroll
                for (int i = 0; i < 4; ++i) a += v[r][i][0] * v[r][i][0] + v[r][i][1] * v[r][i][1] + v[r][i][2] * v[r][i][2] + v[r][i][3] * v[r][i][3];
                rn[r] = __builtin_amdgcn_rsqf(wave_sum(a) * (1.f / 1024.f) + EPS); }
            float acc[4][16];
#pragma unroll
            for (int r = 0; r < 4; ++r)
#pragma unroll
                for (int j = 0; j < 16; ++j) acc[r][j] = 0.f;
#pragma unroll
            for (int i = 0; i < 4; ++i) {
#pragma unroll
                for (int r = 0; r < 4; ++r) { v[r][i] = v[r][i] * rn[r] * g[i];
                    u32x2 w; w.x = pk_bf16(v[r][i][0], v[r][i][1]); w.y = pk_bf16(v[r][i][2], v[r][i][3]);
                    *(u32x2*)(hb + (size_t)(tok0 + r) * 1024 + 4 * (lane + 64 * i)) = w; }
#pragma unroll
                for (int e = 0; e < 4; ++e) {
                    asm volatile("" ::: "memory");
                    const LAS float* wr = W16 + (e * 256 + i * 64 + lane) * 20;
#pragma unroll
                    for (int q = 0; q < 4; ++q) { const f32x4 wv = *(const LAS f32x4*)(wr + 4 * q);
#pragma unroll
                        for (int r = 0; r < 4; ++r)
#pragma unroll
                            for (int z = 0; z < 4; ++z) acc[r][4 * q + z] += v[r][i][e] * wv[z]; }
                }
            }
#define BA_STEP(mask, half) { const bool up = (lane & (mask)) != 0; _Pragma("unroll") for (int r = 0; r < 4; ++r) _Pragma("unroll") for (int j = 0; j < (half); ++j) { \
                const float keep = up ? acc[r][j + (half)] : acc[r][j], send = up ? acc[r][j] : acc[r][j + (half)]; acc[r][j] = keep + __shfl_xor(send, (mask)); } }
            BA_STEP(32, 8) BA_STEP(16, 4) BA_STEP(8, 2) BA_STEP(4, 1)
#undef BA_STEP
#pragma unroll
            for (int r = 0; r < 4; ++r) { float t = acc[r][0]; t += __shfl_xor(t, 1); t += __shfl_xor(t, 2);
                if ((lane & 3) == 0) BA[(size_t)(tok0 + r) * 16 + (lane >> 2)] = t; }
        }
#undef RMS_LOAD
    }
}

constexpr int DLD = 72;
constexpr int DW_X = 0, DW_Y = 9216, DW_ARR = 18432, DW_BYTES = 20352;
constexpr int at_mstart(int j) { return (j + 1) & ~3; }
constexpr int atl_base(int j) { const int a = j >> 2, b = j & 3; return 32 * j - 4 * (2 * a * (a - 1) + a * (b + 1)); }
constexpr int ATL_BLK = 544, BPP = 40, X_PT = 2 * ATL_BLK * 4, Y_T22 = 0, Y_T11T = 32 * BPP * 2, Y_Z = 2 * 32 * BPP * 2;
static_assert(atl_base(32) == ATL_BLK && X_PT + 32 * BPP * 2 <= 9216 && Y_Z + 32 * BPP * 2 <= 9216, "blocked solve LDS map");
constexpr int at_base(int j) { const int a = j >> 2, b = j & 3; return 64 * j - 4 * (2 * a * (a - 1) + a * (b + 1)); }

DI void conv_load(const bf16_t* P, long tok0, bool first_chunk, int pcol, int lane, u32x4 (&xin)[11]) {
    const int tg = lane >> 3, cg = lane & 7;
#pragma unroll
    for (int r = 0; r < 11; ++r) {
        const int tr = 8 * tg + r - 3;
        const bool ok = !(first_chunk && tr < 0);
        u32x4 v = {0u, 0u, 0u, 0u};
        if (ok) v = *(const u32x4*)(P + (size_t)(tok0 + tr) * NP + pcol + 8 * cg);
        xin[r] = v;
    }
}
template <int HALF>
DI void conv_half(const u32x4 (&xin)[11], const float* cw, int lane, float (&out)[4][8]) {
    const int cg = lane & 7;
    f32x4 w[4][2];
#pragma unroll
    for (int j = 0; j < 4; ++j) { w[j][0] = *(const f32x4*)(cw + j * 1536 + 8 * cg); w[j][1] = *(const f32x4*)(cw + j * 1536 + 8 * cg + 4); }
#pragma unroll
    for (int i = 0; i < 4; ++i) {
        float a[8];
#pragma unroll
        for (int e = 0; e < 8; ++e) a[e] = 0.f;
#pragma unroll
        for (int j = 0; j < 4; ++j) {
            const u32x4 x = xin[4 * HALF + i + j];
            const float xv[8] = {bflo(x.x), bfhi(x.x), bflo(x.y), bfhi(x.y), bflo(x.z), bfhi(x.z), bflo(x.w), bfhi(x.w)};
#pragma unroll
            for (int e = 0; e < 8; ++e) a[e] += w[j][e >> 2][e & 3] * xv[e];
        }
#pragma unroll
        for (int e = 0; e < 8; ++e) out[i][e] = siluf_(a[e]);
    }
}
DI void l2norm_half(const float (&v)[4][8], float scale, float (&rs)[4], int lane) {
#pragma unroll
    for (int i = 0; i < 4; ++i) {
        float ss = 0.f;
#pragma unroll
        for (int e = 0; e < 8; ++e) ss += v[i][e] * v[i][e];
        ss += bperm(ss, lane ^ 1); ss += bperm(ss, lane ^ 2); ss += bperm(ss, lane ^ 4);
        rs[i] = __builtin_amdgcn_rsqf(ss + EPS) * scale;
    }
}
DI void write_rowmajor_h(LAS unsigned char* img, const float (&v)[4][8], const float (&rs)[4], int lane, int half) {
    const int tg = lane >> 3, cg = lane & 7;
#pragma unroll
    for (int i = 0; i < 4; ++i) { u32x4 w; w.x = pk_bf16(v[i][0] * rs[i], v[i][1] * rs[i]); w.y = pk_bf16(v[i][2] * rs[i], v[i][3] * rs[i]); w.z = pk_bf16(v[i][4] * rs[i], v[i][5] * rs[i]); w.w = pk_bf16(v[i][6] * rs[i], v[i][7] * rs[i]);
        *(LAS u32x4*)(img + ((8 * tg + 4 * half + i) * DLD + 8 * cg) * 2) = w; }
}
DI void write_transposed_h(LAS unsigned char* img, const float (&v)[4][8], const float (&rs)[4], int lane, int half) {
    const int tg = lane >> 3, cg = lane & 7;
#pragma unroll
    for (int e = 0; e < 8; ++e) { u32x2 w; w.x = pk_bf16(v[0][e] * rs[0], v[1][e] * rs[1]); w.y = pk_bf16(v[2][e] * rs[2], v[3][e] * rs[3]);
        *(LAS u32x2*)(img + ((8 * cg + e) * DLD + 8 * tg + 4 * half) * 2) = w; }
}
DI bf16x8 read_frag(const LAS unsigned char* img, int rt, int s, int fr, int g) {
    const LAS unsigned char* p = img + ((16 * rt + fr) * DLD + 32 * s + 4 * g) * 2;
    return mk8(*(const LAS u32x2*)p, *(const LAS u32x2*)(p + 32));
}

DI bf16x8 read_frag32(const LAS unsigned char* img, int rt, int fr, int g) {
    const LAS unsigned char* p = img + ((16 * rt + fr) * BPP + 4 * g) * 2;
    return mk8(*(const LAS u32x2*)p, *(const LAS u32x2*)(p + 32));
}
DI void delta_prep_unit(unsigned char* ws_, const float* convw, const float* alog, const float* dtb, int parkslot, LAS unsigned char* wl, int unit) {
#define SEC() int lane = threadIdx.x & 63; asm volatile("" : "+v"(lane)); const int fr = lane & 15, g = lane >> 4; (void)fr; (void)g; \
    u32x4* Mb = (u32x4*)(dl + DL_M) + (size_t)dl_cmajor(unit) * 8 * 64 + lane; u32x4* Qb = (u32x4*)(dl + DL_Q) + (size_t)unit * 8 * 64 + lane; \
    u32x2* Nb = (u32x2*)(dl + DL_N) + (size_t)dl_cmajor(unit) * 16 * 64 + lane; u32x2* Ob = (u32x2*)(dl + DL_O) + (size_t)unit * 16 * 64 + lane; \
    u32x4* Sbp = (u32x4*)(dl + DL_S) + (size_t)dl_cmajor(unit) * 8 * 64 + lane; u32x4* Kpark = (u32x4*)(ws_ + WS_PARK) + (size_t)parkslot * 8 * 64 + lane; \
    (void)Mb; (void)Qb; (void)Nb; (void)Ob; (void)Sbp; (void)Kpark;
    unsigned char* dl = ws_ + WS_DELTA;
    const int bh = unit >> 6, c = unit & 63, b = bh >> 3, h = bh & 7;
    const long tok0 = (long)b * L_ + c * 64;
    const bool first = (c == 0);
    const bf16_t* P = (const bf16_t*)(ws_ + WS_P);
    LAS unsigned char* X = wl + DW_X; LAS unsigned char* Y = wl + DW_Y;
    LAS float* sG = (LAS float*)(wl + DW_ARR); LAS float* sBeta = sG + 64; LAS float* sBE = sG + 128; LAS float* sEL = sG + 192; LAS float* sEG = sG + 256;
    const f32x4 z4 = {0.f, 0.f, 0.f, 0.f};
    u32x4 xk[11];
    { SEC(); conv_load(P, tok0, first, PC_K + h * 64, lane, xk); }
    float glast;
    {
        SEC();
        const float* BA = (const float*)(ws_ + WS_BA) + (size_t)(tok0 + lane) * 16;
        const float braw = BA[h], araw = BA[8 + h];
        const float beta = sigmoidf_(braw);
        const float sp = __logf(1.f + __expf(araw + dtb[h]));
        float G = -__expf(alog[h]) * sp;
#pragma unroll
        for (int d = 1; d < 64; d <<= 1) { const float t = bperm(G, lane >= d ? lane - d : lane); if (lane >= d) G += t; }
        glast = __int_as_float(__builtin_amdgcn_readlane(__float_as_int(G), 63));
        const float eg = __expf(G);
        sG[lane] = G; sBeta[lane] = beta; sBE[lane] = beta * eg; sEL[lane] = __expf(glast - G); sEG[lane] = eg;
        wsync();
    }
    const float eGlast = __expf(glast);
    bf16x8 qkP[2][4], vbT[4][2];
    bf16x8 kA[4][2];
    {
        SEC();
        { float v[4][8], rs[4]; conv_half<0>(xk, convw + 512 + h * 64, lane, v); l2norm_half(v, 1.f, rs, lane); write_transposed_h(X, v, rs, lane, 0); write_rowmajor_h(Y, v, rs, lane, 0); }
        { float v[4][8], rs[4]; conv_half<1>(xk, convw + 512 + h * 64, lane, v); l2norm_half(v, 1.f, rs, lane); write_transposed_h(X, v, rs, lane, 1); write_rowmajor_h(Y, v, rs, lane, 1); }
        wsync();
#pragma unroll
        for (int t = 0; t < 4; ++t)
#pragma unroll
            for (int s = 0; s < 2; ++s) { Kpark[(t * 2 + s) * 64] = __builtin_bit_cast(u32x4, read_frag(X, t, s, fr, g)); kA[t][s] = read_frag(Y, t, s, fr, g); }
        wsync();
    }
    u32x4 xq[11];
    {
        SEC();
        conv_load(P, tok0, first, PC_Q + h * 64, lane, xq);
        LAS float* AT = (LAS float*)X;
        f32x4 Gr[4], Br[4]; float Gc[4];
#pragma unroll
        for (int t = 0; t < 4; ++t) { Gr[t] = *(const LAS f32x4*)(sG + 16 * t + 4 * g); Br[t] = *(const LAS f32x4*)(sBeta + 16 * t + 4 * g); Gc[t] = sG[16 * t + fr]; }
#pragma unroll
        for (int nt = 0; nt < 4; ++nt)
#pragma unroll
            for (int mt = nt; mt < 4; ++mt) {
                f32x4 a = z4;
#pragma unroll
                for (int s = 0; s < 2; ++s) a = mfma16(kA[mt][s], kA[nt][s], a);
                const int j = 16 * nt + fr, m0 = 16 * mt + 4 * g;
                if ((mt >> 1) == (nt >> 1)) {
                    const int jl = j & 31, m0l = m0 & 31;
                    const int ms = (jl + 1) & ~3, ja = jl >> 2, jb = jl & 3, base = (nt >> 1) * ATL_BLK + 32 * jl - 4 * (2 * ja * (ja - 1) + ja * (jb + 1));
                    f32x4 o;
#pragma unroll
                    for (int r = 0; r < 4; ++r) o[r] = (m0 + r > j) ? Br[mt][r] * a[r] * __expf(Gr[mt][r] - Gc[nt]) : 0.f;
                    if (m0l >= ms) *(LAS f32x4*)(AT + base + m0l - ms) = o;
                } else {
                    f32x4 o;
#pragma unroll
                    for (int r = 0; r < 4; ++r) o[r] = Br[mt][r] * a[r] * __expf(Gr[mt][r] - Gc[nt]);
                    u32x2 w; w.x = pk_bf16(o[0], o[1]); w.y = pk_bf16(o[2], o[3]);
                    *(LAS u32x2*)(X + X_PT + (j * BPP + m0 - 32) * 2) = w;
                }
            }
    }
    u32x4 xv[11];
    {
        SEC();
        conv_load(P, tok0, first, PC_V + h * 64, lane, xv);
        { float v[4][8], rs[4]; conv_half<0>(xq, convw + h * 64, lane, v); l2norm_half(v, 0.125f, rs, lane); write_rowmajor_h(Y, v, rs, lane, 0); }
        { float v[4][8], rs[4]; conv_half<1>(xq, convw + h * 64, lane, v); l2norm_half(v, 0.125f, rs, lane); write_rowmajor_h(Y, v, rs, lane, 1); }
        wsync();
        f32x4 Gr[4]; float Gc[4];
#pragma unroll
        for (int t = 0; t < 4; ++t) { Gr[t] = *(const LAS f32x4*)(sG + 16 * t + 4 * g); Gc[t] = sG[16 * t + fr]; }
#pragma unroll
        for (int nt = 0; nt < 4; ++nt) {
            bf16x8 qBn[2];
#pragma unroll
            for (int s = 0; s < 2; ++s) { qBn[s] = read_frag(Y, nt, s, fr, g); Qb[(nt * 2 + s) * 64] = __builtin_bit_cast(u32x4, qBn[s]); }
            f32x4 tl[4];
#pragma unroll
            for (int mt = 0; mt < 4; ++mt) {
                f32x4 a = z4;
                if (mt <= nt) {
#pragma unroll
                    for (int s = 0; s < 2; ++s) a = mfma16(kA[mt][s], qBn[s], a);
                    const int cC = 16 * nt + fr, m0 = 16 * mt + 4 * g;
#pragma unroll
                    for (int r = 0; r < 4; ++r) a[r] = (m0 + r <= cC) ? a[r] * __expf(Gc[nt] - Gr[mt][r]) : 0.f;
                }
                tl[mt] = a;
            }
            qkP[0][nt] = pack2(tl[0], tl[1]); qkP[1][nt] = pack2(tl[2], tl[3]);
        }
        wsync();
    }
    {
        SEC();
        { float v[4][8]; conv_half<0>(xv, convw + 1024 + h * 64, lane, v); const f32x4 b0 = *(const LAS f32x4*)(sBeta + 8 * (lane >> 3)); const float rs[4] = {b0[0], b0[1], b0[2], b0[3]}; write_transposed_h(Y, v, rs, lane, 0); }
        { float v[4][8]; conv_half<1>(xv, convw + 1024 + h * 64, lane, v); const f32x4 b0 = *(const LAS f32x4*)(sBeta + 8 * (lane >> 3) + 4); const float rs[4] = {b0[0], b0[1], b0[2], b0[3]}; write_transposed_h(Y, v, rs, lane, 1); }
        wsync();
    }
    bf16x8 kT[4][2];
    {
        SEC();
        const u32x4* Kre_ = Kpark; asm volatile("" : "+v"(Kre_)); const __attribute__((address_space(1))) u32x4* Kre = (const __attribute__((address_space(1))) u32x4*)Kre_;
#pragma unroll
        for (int nt = 0; nt < 4; ++nt)
#pragma unroll
            for (int s = 0; s < 2; ++s) { vbT[nt][s] = read_frag(Y, nt, s, fr, g); kT[nt][s] = __builtin_bit_cast(bf16x8, Kre[(nt * 2 + s) * 64]); }
        wsync();
        const int li = lane & 31, hb = lane >> 5;
        float Tl[32];
        {
            const unsigned at0 = (unsigned)(size_t)X + (unsigned)hb * (ATL_BLK * 4);
#pragma unroll
            for (int j = 31; j >= 0; --j) {
                float a = (li == j) ? 1.f : 0.f;
                unsigned aj = at0;
                if (j < 30) asm volatile("" : "+v"(aj), "+v"(Tl[j + 2]));
                const LAS float* AT = (const LAS float*)aj;
#pragma unroll
                for (int m4 = at_mstart(j); m4 < 32; m4 += 4) {
                    const f32x4 av = *(const LAS f32x4*)(AT + atl_base(j) + m4 - at_mstart(j));
#pragma unroll
                    for (int e = 0; e < 4; ++e) if (m4 + e > j) a = __builtin_fmaf(-Tl[m4 + e], av[e], a);
                }
                Tl[j] = a;
            }
        }
        if (hb) {
#pragma unroll
            for (int q = 0; q < 4; ++q) { u32x4 w; w.x = pk_bf16(Tl[8 * q], Tl[8 * q + 1]); w.y = pk_bf16(Tl[8 * q + 2], Tl[8 * q + 3]); w.z = pk_bf16(Tl[8 * q + 4], Tl[8 * q + 5]); w.w = pk_bf16(Tl[8 * q + 6], Tl[8 * q + 7]);
                *(LAS u32x4*)(Y + Y_T22 + (li * BPP + 8 * q) * 2) = w; }
        } else {
#pragma unroll
            for (int c = 0; c < 32; ++c) *(LAS unsigned short*)(Y + Y_T11T + (c * BPP + li) * 2) = (unsigned short)(pk_bf16(Tl[c], 0.f) & 0xffffu);
        }
        wsync();
#pragma unroll
        for (int mt = 0; mt < 2; ++mt)
#pragma unroll
            for (int nt = 0; nt < 2; ++nt) {
                const f32x4 d = mfma16(read_frag32(X + X_PT, mt, fr, g), read_frag32(Y + Y_T22, nt, fr, g), z4);
                u32x2 w; w.x = pk_bf16(d[0], d[1]); w.y = pk_bf16(d[2], d[3]);
                *(LAS u32x2*)(Y + Y_Z + ((16 * nt + fr) * BPP + 16 * mt + 4 * g) * 2) = w;
            }
        wsync();
        f32x4 t21[2][2];
#pragma unroll
        for (int mt = 0; mt < 2; ++mt)
#pragma unroll
            for (int nt = 0; nt < 2; ++nt) t21[mt][nt] = -mfma16(read_frag32(Y + Y_T11T, mt, fr, g), read_frag32(Y + Y_Z, nt, fr, g), z4);
        wsync();
        const int cb = 32 * hb;
#pragma unroll
        for (int q = 0; q < 4; ++q) {
            const f32x4 s0 = *(const LAS f32x4*)(sBE + cb + 8 * q), s1 = *(const LAS f32x4*)(sBE + cb + 8 * q + 4);
            u32x4 w, w2;
            w.x = pk_bf16(Tl[8 * q], Tl[8 * q + 1]); w.y = pk_bf16(Tl[8 * q + 2], Tl[8 * q + 3]); w.z = pk_bf16(Tl[8 * q + 4], Tl[8 * q + 5]); w.w = pk_bf16(Tl[8 * q + 6], Tl[8 * q + 7]);
            w2.x = pk_bf16(Tl[8 * q] * s0[0], Tl[8 * q + 1] * s0[1]); w2.y = pk_bf16(Tl[8 * q + 2] * s0[2], Tl[8 * q + 3] * s0[3]);
            w2.z = pk_bf16(Tl[8 * q + 4] * s1[0], Tl[8 * q + 5] * s1[1]); w2.w = pk_bf16(Tl[8 * q + 6] * s1[2], Tl[8 * q + 7] * s1[3]);
            *(LAS u32x4*)(X + (lane * DLD + cb + 8 * q) * 2) = w;
            *(LAS u32x4*)(Y + (lane * DLD + cb + 8 * q) * 2) = w2;
            if (!hb) { const u32x4 zz = {0u, 0u, 0u, 0u}; *(LAS u32x4*)(X + (lane * DLD + 32 + 8 * q) * 2) = zz; *(LAS u32x4*)(Y + (lane * DLD + 32 + 8 * q) * 2) = zz; }
        }
#pragma unroll
        for (int mt = 0; mt < 2; ++mt)
#pragma unroll
            for (int nt = 0; nt < 2; ++nt) {
                const f32x4 sc = *(const LAS f32x4*)(sBE + 16 * mt + 4 * g);
                const f32x4 d = t21[mt][nt], d2 = d * sc;
                u32x2 w, w2; w.x = pk_bf16(d[0], d[1]); w.y = pk_bf16(d[2], d[3]); w2.x = pk_bf16(d2[0], d2[1]); w2.y = pk_bf16(d2[2], d2[3]);
                *(LAS u32x2*)(X + ((32 + 16 * nt + fr) * DLD + 16 * mt + 4 * g) * 2) = w;
                *(LAS u32x2*)(Y + ((32 + 16 * nt + fr) * DLD + 16 * mt + 4 * g) * 2) = w2;
            }
        wsync();
    }
    SEC();
    f32x4 ELr[4]; float EGc[4];
#pragma unroll
    for (int t = 0; t < 4; ++t) { ELr[t] = *(const LAS f32x4*)(sEL + 16 * t + 4 * g); EGc[t] = sEG[16 * t + fr]; }
    {
#pragma unroll
        for (int nt = 0; nt < 4; ++nt) {
            f32x4 Ut[4];
#pragma unroll
            for (int mt = 0; mt < 4; ++mt) { f32x4 a = z4;
#pragma unroll
                for (int s = 0; s < 2; ++s) a = mfma16(read_frag(X, mt, s, fr, g), vbT[nt][s], a);
                Ut[mt] = a; }
            bf16x8 Ub[2], Usb[2];
#pragma unroll
            for (int s = 0; s < 2; ++s) { Ub[s] = pack2(Ut[2 * s], Ut[2 * s + 1]); Usb[s] = pack2(Ut[2 * s] * ELr[2 * s], Ut[2 * s + 1] * ELr[2 * s + 1]); }
#pragma unroll
            for (int mt = 0; mt < 4; ++mt) { f32x4 a = z4;
#pragma unroll
                for (int s = 0; s < 2; ++s) a = mfma16(kT[mt][s], Usb[s], a);
                u32x2 nw; nw.x = pk_bf16(a[0], a[1]); nw.y = pk_bf16(a[2], a[3]); __builtin_nontemporal_store(nw, &Nb[(mt * 4 + nt) * 64]); }
#pragma unroll
            for (int n2 = 0; n2 < 4; ++n2) { f32x4 a = z4;
#pragma unroll
                for (int s = 0; s < 2; ++s) a = mfma16(Ub[s], qkP[s][n2], a);
                u32x2 ow; ow.x = pk_bf16(a[0], a[1]); ow.y = pk_bf16(a[2], a[3]); __builtin_nontemporal_store(ow, &Ob[(nt * 4 + n2) * 64]); }
            asm volatile("" ::: "memory");
        }
    }
    {
        u32x4 qbv[2][4];
        const u32x4* Qre_ = Qb; asm volatile("" : "+v"(Qre_)); const __attribute__((address_space(1))) u32x4* Qre = (const __attribute__((address_space(1))) u32x4*)Qre_;
#pragma unroll
        for (int s2 = 0; s2 < 2; ++s2)
#pragma unroll
            for (int nt = 0; nt < 4; ++nt) qbv[s2][nt] = Qre[(nt * 2 + s2) * 64];
#pragma unroll
        for (int s2 = 0; s2 < 2; ++s2) {
            bf16x8 Wb[2][2], Wsb[2][2];
#pragma unroll
            for (int w = 0; w < 2; ++w) {
                f32x4 Wt[4];
#pragma unroll
                for (int mt = 0; mt < 4; ++mt) { f32x4 a = z4;
#pragma unroll
                    for (int s = 0; s < 2; ++s) a = mfma16(read_frag(Y, mt, s, fr, g), kT[2 * s2 + w][s], a);
                    Wt[mt] = a; }
#pragma unroll
                for (int s = 0; s < 2; ++s) { Wb[w][s] = pack2(Wt[2 * s], Wt[2 * s + 1]); Wsb[w][s] = pack2(Wt[2 * s] * ELr[2 * s], Wt[2 * s + 1] * ELr[2 * s + 1]); }
            }
#pragma unroll
            for (int nt = 0; nt < 4; ++nt) {
                f32x4 mv[2], qv[2];
                const u32x4 qb = qbv[s2][nt];
#pragma unroll
                for (int w = 0; w < 2; ++w) {
                    f32x4 a = z4, q = z4;
#pragma unroll
                    for (int s = 0; s < 2; ++s) { a = mfma16(Wsb[w][s], kT[nt][s], a); q = mfma16(Wb[w][s], qkP[s][nt], q); }
                    const int dkp0 = 16 * (2 * s2 + w) + 4 * g, dk = 16 * nt + fr;
                    const unsigned q01 = w ? qb.z : qb.x, q23 = w ? qb.w : qb.y;
                    const float qg[4] = {bflo(q01), bfhi(q01), bflo(q23), bfhi(q23)};
#pragma unroll
                    for (int r = 0; r < 4; ++r) { mv[w][r] = ((dkp0 + r == dk) ? eGlast : 0.f) - a[r]; qv[w][r] = qg[r] * EGc[nt] - q[r]; }
                }
                __builtin_nontemporal_store(__builtin_bit_cast(u32x4, pack2(mv[0], mv[1])), &Mb[(nt * 2 + s2) * 64]);
                __builtin_nontemporal_store(__builtin_bit_cast(u32x4, pack2(qv[0], qv[1])), &Qb[(nt * 2 + s2) * 64]);
            }
            asm volatile("" ::: "memory");
        }
    }
}
#undef SEC
template <int W>
DI void pool_item(const bf16_t* P, bf16_t* PM, int tb, int c8) {
    const int t0 = tb * 8, tin = t0 & (L_ - 1);
    u32x4 x[W + 7];
#pragma unroll
    for (int r = 0; r < W + 7; ++r) {
        const int rel = r - (W - 1);
        u32x4 v = {0u, 0u, 0u, 0u};
        if (tin + rel >= 0) v = *(const u32x4*)(P + (size_t)(t0 + rel) * NP + PC_U + 8 * c8);
        x[r] = v;
    }
    float s[8];
#pragma unroll
    for (int e = 0; e < 8; ++e) s[e] = 0.f;
#pragma unroll
    for (int r = 0; r < W - 1; ++r) { s[0] += bflo(x[r].x); s[1] += bfhi(x[r].x); s[2] += bflo(x[r].y); s[3] += bfhi(x[r].y); s[4] += bflo(x[r].z); s[5] += bfhi(x[r].z); s[6] += bflo(x[r].w); s[7] += bfhi(x[r].w); }
#pragma unroll
    for (int i = 0; i < 8; ++i) {
        const u32x4 c = x[i + W - 1];
        const float u0[8] = {bflo(c.x), bfhi(c.x), bflo(c.y), bfhi(c.y), bflo(c.z), bfhi(c.z), bflo(c.w), bfhi(c.w)};
#pragma unroll
        for (int e = 0; e < 8; ++e) s[e] += u0[e];
        const int cnt = (tin + i + 1 < W) ? tin + i + 1 : W;
        const float inv = 1.f / (float)cnt;
        u32x4 o; o.x = pk_bf16(s[0] * inv - u0[0], s[1] * inv - u0[1]); o.y = pk_bf16(s[2] * inv - u0[2], s[3] * inv - u0[3]);
        o.z = pk_bf16(s[4] * inv - u0[4], s[5] * inv - u0[5]); o.w = pk_bf16(s[6] * inv - u0[6], s[7] * inv - u0[7]);
        *(u32x4*)(PM + (size_t)(t0 + i) * 512 + 8 * c8) = o;
        const u32x4 d = x[i];
        s[0] -= bflo(d.x); s[1] -= bfhi(d.x); s[2] -= bflo(d.y); s[3] -= bfhi(d.y); s[4] -= bflo(d.z); s[5] -= bfhi(d.z); s[6] -= bflo(d.w); s[7] -= bfhi(d.w);
    }
}
DI void pool_prep(const Frame& F) {
    const bf16_t* P = (const bf16_t*)(F.ws + WS_P); bf16_t* PM = (bf16_t*)(F.ws + WS_PM);
    for (int wi = F.bid * 8 + F.wid; wi < 4 * (T_ / 32); wi += F.G * 8) {
        const int grp = wi & 3, tb = (wi >> 2) * 4 + (F.lane >> 4), c8 = grp * 16 + (F.lane & 15);
        if (grp == 0) pool_item<2>(P, PM, tb, c8);
        else if (grp == 1) pool_item<4>(P, PM, tb, c8);
        else if (grp == 2) pool_item<8>(P, PM, tb, c8);
        else pool_item<16>(P, PM, tb, c8);
    }
}

constexpr int SC_NS = 14, SC_SLOT = 10240, SC_FLAGS = SC_NS * SC_SLOT;
DI void delta_scan(const Frame& F) {
    const int lane = F.lane;
    LAS unsigned char* ring = F.lds;
    volatile LAS int* ready = (volatile LAS int*)(F.lds + SC_FLAGS); volatile LAS int* consumed = ready + 64;
    if (F.tid < 65) ready[F.tid] = 0;
    __syncthreads();
    unsigned char* dl = F.ws + WS_DELTA;
    for (int job = F.bid; job < 256; job += F.G) {
        const int chain = (job & 7) * 8 + (job >> 5), nt = (job >> 3) & 3;
        const u32x4* Mb = (const u32x4*)(dl + DL_M) + (size_t)chain * 8 * 64 + lane;
        const u32x2* Nb = (const u32x2*)(dl + DL_N) + (size_t)chain * 16 * 64 + lane;
        if (F.wid == 0) {
            u32x4* Sb = (u32x4*)(dl + DL_S) + (size_t)chain * 8 * 64 + lane;
            f32x4 S[4];
#pragma unroll
            for (int m = 0; m < 4; ++m) S[m] = (f32x4){0.f, 0.f, 0.f, 0.f};
            u32x4 Mq[8]; u32x2 Nr[4]; int nready;
            { unsigned sp = 0; while (ready[0] == 0) { __builtin_amdgcn_s_sleep(1); if (++sp > (1u << 22)) break; } }
            asm volatile("" ::: "memory");
#pragma unroll
            for (int f = 0; f < 8; ++f) Mq[f] = *(const LAS u32x4*)(ring + lane * 16 + f * 1024);
#pragma unroll
            for (int m = 0; m < 4; ++m) Nr[m] = *(const LAS u32x2*)(ring + 8192 + lane * 8 + m * 512);
            nready = ready[1];
            wsync();
            if (lane == 0) *consumed = 1;
            for (int c = 0; c < 64; ++c) {
                bf16x8 Sf[2];
#pragma unroll
                for (int s = 0; s < 2; ++s) { Sf[s] = pack2(S[2 * s], S[2 * s + 1]); __builtin_nontemporal_store(__builtin_bit_cast(u32x4, Sf[s]), &Sb[((size_t)c * 64 * 8 + nt * 2 + s) * 64]); }
#pragma unroll
                for (int m = 0; m < 4; ++m) { f32x4 a = {bflo(Nr[m].x), bfhi(Nr[m].x), bflo(Nr[m].y), bfhi(Nr[m].y)};
#pragma unroll
                    for (int s = 0; s < 2; ++s) a = mfma16(__builtin_bit_cast(bf16x8, Mq[m * 2 + s]), Sf[s], a);
                    S[m] = a; }
                __builtin_amdgcn_sched_barrier(0);
                if (c + 1 < 64) {
                    if (nready == 0) { unsigned sp = 0; while (ready[c + 1] == 0) { __builtin_amdgcn_s_sleep(1); if (++sp > (1u << 22)) break; } }
                    asm volatile("" ::: "memory");
                    const LAS unsigned char* slot = ring + ((c + 1) % SC_NS) * SC_SLOT;
#pragma unroll
                    for (int f = 0; f < 8; ++f) Mq[f] = *(const LAS u32x4*)(slot + lane * 16 + f * 1024);
#pragma unroll
                    for (int m = 0; m < 4; ++m) Nr[m] = *(const LAS u32x2*)(slot + 8192 + lane * 8 + m * 512);
                    nready = ready[(c + 2) & 63];
                    wsync();
                    if (lane == 0) *consumed = c + 2;
                }
            }
        } else {
            for (int c = F.wid - 1; c < 64; c += 7) {
                u32x4 Mq[8]; u32x2 Nq[4];
#pragma unroll
                for (int f = 0; f < 8; ++f) Mq[f] = Mb[((size_t)c * 64 * 8 + f) * 64];
#pragma unroll
                for (int m = 0; m < 4; ++m) Nq[m] = Nb[((size_t)c * 64 * 16 + m * 4 + nt) * 64];
                { unsigned sp = 0; while (c - *consumed >= SC_NS) { __builtin_amdgcn_s_sleep(1); if (++sp > (1u << 22)) break; } }
                asm volatile("" ::: "memory");
                LAS unsigned char* slot = ring + (c % SC_NS) * SC_SLOT + lane * 16;
#pragma unroll
                for (int f = 0; f < 8; ++f) *(LAS u32x4*)(slot + f * 1024) = Mq[f];
#pragma unroll
                for (int m = 0; m < 4; ++m) *(LAS u32x2*)(ring + (c % SC_NS) * SC_SLOT + 8192 + lane * 8 + m * 512) = Nq[m];
                wsync();
                if (lane == 0) ready[c] = 1;
            }
        }
    }
}

struct DoutIn { bf16x8 Sf[4][2], Qf[4][2]; u32x2 Ot[16]; };
DI void delta_out_load(const Frame& F, int lane, int unit, DoutIn& d) {
    unsigned char* dl = F.ws + WS_DELTA;
    const u32x4* Qb = (const u32x4*)(dl + DL_Q) + (size_t)unit * 8 * 64 + lane;
    const u32x4* Sb = (const u32x4*)(dl + DL_S) + (size_t)dl_cmajor(unit) * 8 * 64 + lane;
    const u32x2* Ob = (const u32x2*)(dl + DL_O) + (size_t)unit * 16 * 64 + lane;
#pragma unroll
    for (int t = 0; t < 4; ++t)
#pragma unroll
        for (int s = 0; s < 2; ++s) { d.Sf[t][s] = __builtin_bit_cast(bf16x8, Sb[(t * 2 + s) * 64]); d.Qf[t][s] = __builtin_bit_cast(bf16x8, Qb[(t * 2 + s) * 64]); }
#pragma unroll
    for (int t = 0; t < 16; ++t) d.Ot[t] = Ob[t * 64];
}
DI void dout_z_issue(const Frame& F, int lane, int unit, u32x4 (&zr)[8]) {
    const int bh = unit >> 6, c = unit & 63, b = bh >> 3, h = bh & 7;
    const bf16_t* P = (const bf16_t*)(F.ws + WS_P) + ((size_t)b * L_ + c * 64) * NP + PC_Z + h * 64 + 8 * (lane & 7);
#pragma unroll
    for (int p = 0; p < 8; ++p) zr[p] = *(const u32x4*)(P + (size_t)(8 * p + (lane >> 3)) * NP);
}
DI void dout_z_put(LAS unsigned char* img, int lane, const u32x4 (&zr)[8]) {
#pragma unroll
    for (int p = 0; p < 8; ++p) *(LAS u32x4*)(img + ((8 * p + (lane >> 3)) * DLD + 8 * (lane & 7)) * 2) = zr[p];
}
DI void delta_out_compute(const Frame& F, int lane, int unit, const DoutIn& d, LAS unsigned char* img, const f32x4 (&dn)[4]) {
    asm volatile("" : "+v"(lane));
    const int fr = lane & 15, g = lane >> 4;
    const int bh = unit >> 6, c = unit & 63, b = bh >> 3, h = bh & 7;
    const long tok0 = (long)b * L_ + c * 64;
    bf16_t* OA = (bf16_t*)(F.ws + WS_OA);
#pragma unroll
    for (int nt = 0; nt < 4; ++nt) {
        LAS unsigned char* zrow = img + ((16 * nt + fr) * DLD + 4 * g) * 2;
        u32x2 zz[4];
#pragma unroll
        for (int mt = 0; mt < 4; ++mt) zz[mt] = *(const LAS u32x2*)(zrow + 32 * mt);
        f32x4 o[4]; float ss = 0.f;
#pragma unroll
        for (int mt = 0; mt < 4; ++mt) { const u32x2 ob = d.Ot[mt * 4 + nt]; f32x4 a = {bflo(ob.x), bfhi(ob.x), bflo(ob.y), bfhi(ob.y)};
#pragma unroll
            for (int s = 0; s < 2; ++s) a = mfma16(d.Sf[mt][s], d.Qf[nt][s], a);
            o[mt] = a; ss += a[0] * a[0] + a[1] * a[1] + a[2] * a[2] + a[3] * a[3]; }
        ss += __shfl_xor(ss, 16); ss += __shfl_xor(ss, 32);
        const float rn = __builtin_amdgcn_rsqf(ss * (1.f / 64.f) + EPS);
#pragma unroll
        for (int mt = 0; mt < 4; ++mt) {
            const float z[4] = {bflo(zz[mt].x), bfhi(zz[mt].x), bflo(zz[mt].y), bfhi(zz[mt].y)};
            float y[4];
#pragma unroll
            for (int r = 0; r < 4; ++r) y[r] = o[mt][r] * rn * dn[mt][r] * siluf_(z[r]);
            u32x2 w; w.x = pk_bf16(y[0], y[1]); w.y = pk_bf16(y[2], y[3]);
            *(LAS u32x2*)(zrow + 32 * mt) = w;
        }
    }
    wsync();
#pragma unroll
    for (int p = 0; p < 8; ++p) {
        const int row = 8 * p + (lane >> 3);
        const u32x4 v = *(const LAS u32x4*)(img + (row * DLD + 8 * (lane & 7)) * 2);
        *(u32x4*)(OA + (size_t)(tok0 + row) * 512 + h * 64 + 8 * (lane & 7)) = v;
    }
}
DI void delta_out(const Frame& F) {
    const int u0 = F.bid * 8 + F.wid;
    LAS unsigned char* imgA = F.lds + F.wid * DW_BYTES; LAS unsigned char* imgB = imgA + 9216;
    for (int u = u0; u < 4096; u += F.G * 8 * 2) {
        const int u2 = u + F.G * 8; const bool has2 = u2 < 4096;
        int lane = F.lane; asm volatile("" : "+v"(lane));
        f32x4 dn[4];
#pragma unroll
        for (int mt = 0; mt < 4; ++mt) dn[mt] = *(const f32x4*)(F.in[I_DNN] + 16 * mt + 4 * (lane >> 4));
        u32x4 zA[8], zB[8];
        dout_z_issue(F, lane, u, zA); dout_z_issue(F, lane, has2 ? u2 : u, zB);
        asm volatile("" ::: "memory");
        DoutIn A, B;
        delta_out_load(F, lane, u, A);
        dout_z_put(imgA, lane, zA); dout_z_put(imgB, lane, zB);
        asm volatile("" ::: "memory");
        __builtin_amdgcn_sched_barrier(0);
        delta_out_load(F, lane, has2 ? u2 : u, B);
        __builtin_amdgcn_sched_barrier(0);
        wsync();
        delta_out_compute(F, lane, u, A, imgA, dn);
        if (has2) delta_out_compute(F, lane, u2, B, imgB, dn);
        wsync();
    }
}

constexpr int RT_PITCH = 36;
constexpr int RT_CNT = 1024 * RT_PITCH * 4;
DI void p7_router(const Frame& F) {
    LAS float* W = (LAS float*)F.lds;
    LAS int* lcount = (LAS int*)(F.lds + RT_CNT); LAS int* lbase = lcount + 32; LAS int* rec_e = lbase + 32; LAS int* rec_s = rec_e + 512; LAS float* rec_w = (LAS float*)(rec_s + 512);
    const float* x1 = F.in[I_X]; const bf16_t* dx = (const bf16_t*)(F.ws + WS_PM); unsigned char* h2 = F.ws + WS_H;
    int* gcount = (int*)(F.ws + WS_CTL + CW_CNT); int* list = (int*)(F.ws + WS_LIST); float* topw = (float*)(F.ws + WS_TOPW);
    const int lane = F.lane;
    for (int i = F.tid; i < 1024 * 8; i += 512) { const int k = i >> 3, q = i & 7; const f32x4 v = *(const f32x4*)(F.in[I_WR] + k * 32 + q * 4);
        *(LAS f32x4*)(W + ((k & 3) * 256 + (k >> 2)) * RT_PITCH + q * 4) = v; }
    f32x4 gf[4];
#pragma unroll
    for (int i = 0; i < 4; ++i) gf[i] = *(const f32x4*)(F.in[I_GFFN] + 4 * (lane + 64 * i));
    const float brt = F.in[I_BR][lane >> 1];
    for (int chunk = F.bid; chunk < T_ / 128; chunk += F.G) {
        if (F.tid < 32) lcount[F.tid] = 0;
        __syncthreads();
        const int tokc = chunk * 128;
        f32x4 vn[4]; u32x2 dn2[4];
        { const int tok = tokc + F.wid * 16;
#pragma unroll
          for (int i = 0; i < 4; ++i) { dn2[i] = *(const u32x2*)(dx + (size_t)tok * 1024 + 4 * (lane + 64 * i)); vn[i] = *(const f32x4*)(x1 + (size_t)tok * 1024 + 4 * (lane + 64 * i)); } }
        for (int it = 0; it < 16; ++it) {
            const int tl = F.wid * 16 + it, tok = tokc + tl;
            f32x4 v[4]; float ss = 0.f;
#pragma unroll
            for (int i = 0; i < 4; ++i) { const u32x2 d2 = dn2[i]; v[i] = vn[i];
                v[i][0] += bflo(d2.x); v[i][1] += bfhi(d2.x); v[i][2] += bflo(d2.y); v[i][3] += bfhi(d2.y); ss += v[i][0] * v[i][0] + v[i][1] * v[i][1] + v[i][2] * v[i][2] + v[i][3] * v[i][3];
                u32x2 xw; xw.x = pk_bf16(v[i][0], v[i][1]); xw.y = pk_bf16(v[i][2], v[i][3]);
                *(u32x2*)((bf16_t*)dx + (size_t)tok * 1024 + 4 * (lane + 64 * i)) = xw; }
            { const int tokn = tokc + F.wid * 16 + ((it < 15) ? it + 1 : it);
#pragma unroll
              for (int i = 0; i < 4; ++i) { dn2[i] = *(const u32x2*)(dx + (size_t)tokn * 1024 + 4 * (lane + 64 * i)); vn[i] = *(const f32x4*)(x1 + (size_t)tokn * 1024 + 4 * (lane + 64 * i)); } }
            ss = wave_sum(ss);
            const float r = __builtin_amdgcn_rsqf(ss * (1.f / 1024.f) + EPS);
            float a[32];
#pragma unroll
            for (int e = 0; e < 32; ++e) a[e] = 0.f;
#pragma unroll
            for (int i = 0; i < 4; ++i) {
                f32x4 hn = v[i] * r * gf[i];
                *(unsigned*)(h2 + (size_t)tok * 1024 + 4 * (lane + 64 * i)) = pk4_fp8(hn[0] * SC_H2, hn[1] * SC_H2, hn[2] * SC_H2, hn[3] * SC_H2);
#pragma unroll
                for (int e = 0; e < 4; ++e) {
                    const LAS float* wr = W + (e * 256 + i * 64 + lane) * RT_PITCH;
#pragma unroll
                    for (int q = 0; q < 8; ++q) { const f32x4 wv = *(const LAS f32x4*)(wr + 4 * q);
#pragma unroll
                        for (int z = 0; z < 4; ++z) a[4 * q + z] += hn[e] * wv[z]; }
                }
            }
#define RT_STEP(mask, half) { const bool up = (lane & (mask)) != 0; _Pragma("unroll") for (int i = 0; i < (half); ++i) { const float keep = up ? a[i + (half)] : a[i], send = up ? a[i] : a[i + (half)]; a[i] = keep + __shfl_xor(send, (mask)); } }
            RT_STEP(32, 16) RT_STEP(16, 8) RT_STEP(8, 4) RT_STEP(4, 2) RT_STEP(2, 1)
#undef RT_STEP
            float val = a[0] + __shfl_xor(a[0], 1) + brt;
            float tv[4]; int te[4];
#pragma unroll
            for (int k = 0; k < 4; ++k) {
                float m = val;
#pragma unroll
                for (int d = 32; d >= 1; d >>= 1) m = fmaxf(m, __shfl_xor(m, d));
                const unsigned long long bal = __ballot(val == m);
                const int e = (__ffsll((long long)bal) - 1) >> 1;
                tv[k] = m; te[k] = e;
                if ((lane >> 1) == e) val = -INFINITY;
            }
            const float e1 = __expf(tv[1] - tv[0]), e2 = __expf(tv[2] - tv[0]), e3 = __expf(tv[3] - tv[0]);
            const float inv = 1.f / (1.f + e1 + e2 + e3);
            if (lane < 4) {
                const int ek = lane == 0 ? te[0] : (lane == 1 ? te[1] : (lane == 2 ? te[2] : te[3]));
                const float wk = (lane == 0 ? 1.f : (lane == 1 ? e1 : (lane == 2 ? e2 : e3))) * inv;
                const int slot = atomicAdd((int*)(lcount + ek), 1);
                rec_e[tl * 4 + lane] = ek; rec_s[tl * 4 + lane] = slot; rec_w[tl * 4 + lane] = wk;
            }
        }
        __syncthreads();
        if (F.tid < 32) lbase[F.tid] = atomicAdd(gcount + F.tid, lcount[F.tid]);
        __syncthreads();
        { const int idx = F.tid, e = rec_e[idx];
          list[e * LISTCAP + lbase[e] + rec_s[idx]] = tokc * 4 + idx; topw[tokc * 4 + idx] = rec_w[idx]; }
        __syncthreads();
    }
}

DI void moe_table(const Frame& F, LAS MoeTbl* tb) {
    const int* gcount = (const int*)(F.ws + WS_CTL + CW_CNT);
    if (F.tid < NE) tb->cnt[F.tid] = gcount[F.tid];
    __syncthreads();
    if (F.tid == 0) { int acc = 0; for (int e = 0; e < NE; ++e) { tb->rts[e] = acc; acc += (tb->cnt[e] + 255) >> 8; } tb->rts[NE] = acc; }
    __syncthreads();
}

DI void p10_final(const Frame& F) {
    const unsigned char* yk = F.ws + WS_DELTA; const float* topw = (const float*)(F.ws + WS_TOPW); float* out = F.out; const bf16_t* dx = (const bf16_t*)(F.ws + WS_PM);
    const int lane = F.lane;
    f32x4 gf[4];
#pragma unroll
    for (int i = 0; i < 4; ++i) gf[i] = *(const f32x4*)(F.in[I_GFIN] + 4 * (lane + 64 * i));
    for (int tok0 = (F.bid * 8 + F.wid) * 2; tok0 < T_; tok0 += F.G * 8 * 2) {
        f32x4 v[2][4]; unsigned y[2][4][4]; f32x4 tw[2];
#pragma unroll
        for (int r = 0; r < 2; ++r) { tw[r] = *(const f32x4*)(topw + (size_t)(tok0 + r) * 4) * (1.f / SC_Y);
#pragma unroll
            for (int i = 0; i < 4; ++i) { const u32x2 d2 = *(const u32x2*)(dx + (size_t)(tok0 + r) * 1024 + 4 * (lane + 64 * i));
                v[r][i] = (f32x4){bflo(d2.x), bfhi(d2.x), bflo(d2.y), bfhi(d2.y)}; }
#pragma unroll
            for (int k = 0; k < 4; ++k)
#pragma unroll
                for (int i = 0; i < 4; ++i) y[r][k][i] = *(const unsigned*)(yk + ((size_t)(tok0 + r) * 4 + k) * 1024 + 4 * (lane + 64 * i)); }
#pragma unroll
        for (int r = 0; r < 2; ++r) {
#pragma unroll
            for (int k = 0; k < 4; ++k)
#pragma unroll
                for (int i = 0; i < 4; ++i) { const f32x2 lo = __builtin_amdgcn_cvt_pk_f32_fp8(y[r][k][i], false), hi = __builtin_amdgcn_cvt_pk_f32_fp8(y[r][k][i], true);
                    v[r][i][0] += tw[r][k] * lo.x; v[r][i][1] += tw[r][k] * lo.y; v[r][i][2] += tw[r][k] * hi.x; v[r][i][3] += tw[r][k] * hi.y; }
            float ss = 0.f;
#pragma unroll
            for (int i = 0; i < 4; ++i) ss += v[r][i][0] * v[r][i][0] + v[r][i][1] * v[r][i][1] + v[r][i][2] * v[r][i][2] + v[r][i][3] * v[r][i][3];
            ss = wave_sum(ss);
            const float rn = __builtin_amdgcn_rsqf(ss * (1.f / 1024.f) + EPS);
#pragma unroll
            for (int i = 0; i < 4; ++i) *(f32x4*)(out + (size_t)(tok0 + r) * 1024 + 4 * (lane + 64 * i)) = v[r][i] * rn * gf[i];
        }
    }
}

__global__ void __launch_bounds__(512, 2) fwd(Params prm) {
    extern __shared__ __attribute__((aligned(16))) unsigned char lds_raw[];
#define T0() (wid_k == 0 && __builtin_amdgcn_mbcnt_hi(~0u, __builtin_amdgcn_mbcnt_lo(~0u, 0u)) == 0u)
#define FRAME() Frame F; F.lds = (LAS unsigned char*)lds_raw; { int t_ = wid_k * 64 + (int)__builtin_amdgcn_mbcnt_hi(~0u, __builtin_amdgcn_mbcnt_lo(~0u, 0u)); asm volatile("" : "+v"(t_)); F.tid = t_; } F.lane = F.tid & 63; F.wid = __builtin_amdgcn_readfirstlane(F.tid >> 6); \
    F.G = gridDim.x; F.bid = blockIdx.x; _Pragma("unroll") for (int i_ = 0; i_ < 20; ++i_) F.in[i_] = prm.in[i_]; F.out = prm.out; F.ws = prm.ws; unsigned char* ws = F.ws; (void)ws;
    LAS unsigned char* const ldsb = (LAS unsigned char*)lds_raw;
    const int wid_k = __builtin_amdgcn_readfirstlane(threadIdx.x >> 6);
    if (threadIdx.x == 0) *(LAS u32x4*)(ldsb + LDS_BARW) = (u32x4){0u, 0u, 0u, 0u};
    __syncthreads();
    XcdBarrier bar; bar.bar = (unsigned*)(prm.ws + WS_CTL + CW_BAR); bar.x = 0; bar.st = (volatile LAS unsigned*)(ldsb + LDS_BARW);
    if (N_LAUNCHES == 1) bar = xcd_barrier_post((unsigned*)(prm.ws + WS_CTL + CW_BAR), (volatile LAS unsigned*)(ldsb + LDS_BARW), T0());
    const int lo = prm.ph_lo, hi = prm.ph_hi;
#ifndef PHASE_MASK
#define PHASE_MASK 0x7ff
#endif
#define IN(k) (((PHASE_MASK >> (k)) & 1) && lo <= (k) && (k) < hi)
#define SEAM(k) do { if (IN(k) && IN((k) + 1)) xcd_barrier(bar, T0()); } while (0)
#ifndef REPEAT_MASK
#define REPEAT_MASK 0
#endif
#define REP(k) for (int rep_ = 0; rep_ < (((REPEAT_MASK >> (k)) & 1) ? 2 : 1); ++rep_)
    LAS MoeTbl* tb = (LAS MoeTbl*)(ldsb + pg8::STAGE_BYTES);

    REP(0) if (IN(0)) { if (rep_) xcd_barrier(bar, T0()); FRAME(); moe_weights(F, F.bid, F.G); p0_prologue(F); }
    SEAM(0);
    REP(1) if (IN(1)) { if (rep_) xcd_barrier(bar, T0());
        FRAME();
        DenseSched S; S.A = (const char*)(ws + WS_H); S.Bt = (const char*)(ws + WS_WIN); S.K = 1024; S.so.init(T_, NP, F.G, F.bid); S.mixgate = 1;
        EpiP E{(bf16_t*)(ws + WS_P)};
        pg8::gemm_phase(F.lds, F.tid, 1024, S, E);
    }
    SEAM(1);
    REP(2) if (IN(2)) { if (rep_) xcd_barrier(bar, T0());
        { FRAME(); pool_prep(F); }
        { FRAME();
          LAS unsigned char* wl = F.lds + F.wid * DW_BYTES;
          for (int u = F.bid * 8 + F.wid; u < 4096; u += F.G * 8) delta_prep_unit(F.ws, F.in[I_CONVW], F.in[I_ALOG], F.in[I_DTB], F.bid * 8 + F.wid, wl, u); }
    }
    SEAM(2);
    REP(3) if (IN(3)) { if (rep_) xcd_barrier(bar, T0()); FRAME(); delta_scan(F); }
    SEAM(3);
    REP(4) if (IN(4)) { if (rep_) xcd_barrier(bar, T0()); FRAME(); delta_out(F); }
    SEAM(4);
    REP(5) if (IN(5)) { if (rep_) xcd_barrier(bar, T0());
        FRAME();
        UpSched S; S.A0 = (const char*)(ws + WS_OA); S.A1 = (const char*)(ws + WS_PM); S.B0 = (const char*)(ws + WS_WA); S.B1 = (const char*)(ws + WS_WB); S.so.init(T_, 1024, F.G, F.bid);
        EpiUp E{(const bf16_t*)(ws + WS_P), (bf16_t*)(ws + WS_H)};
        pg8::gemm_phase(F.lds, F.tid, 512, S, E);
    }
    SEAM(5);
    REP(6) if (IN(6)) { if (rep_) xcd_barrier(bar, T0());
        FRAME();
        DenseSched S; S.A = (const char*)(ws + WS_H); S.Bt = (const char*)(ws + WS_WOUT); S.K = 1024; S.so.init(T_, 1024, F.G, F.bid); S.mixgate = 0;
        EpiStoreBf16 E{(bf16_t*)(ws + WS_PM), 1024};
        pg8::gemm_phase(F.lds, F.tid, 1024, S, E);
    }
    SEAM(6);
    REP(7) if (IN(7)) { if (rep_) xcd_barrier(bar, T0()); FRAME(); p7_router(F); }
    SEAM(7);
    REP(8) if (IN(8)) { if (rep_) xcd_barrier(bar, T0());
        FRAME();
        moe_table(F, tb);
        MoeSched S; S.A = (const char*)(ws + WS_H); S.Bt = (const char*)(ws + WS_WGU); S.list = (const int*)(ws + WS_LIST); S.tb = tb; S.K = 512; S.NT = 8; S.RG = 4; S.bid = F.bid;
        S.bstride = (size_t)2048 * 1024; S.gather = true;
        EpiGateUp E{ws + WS_P, F.in[I_BGU]};
        pg8::gemm_phase<EpiGateUp, MoeSched, true>(F.lds, F.tid, 512, S, E, E8_W, E8_H2);
    }
    SEAM(8);
    REP(9) if (IN(9)) { if (rep_) xcd_barrier(bar, T0());
        FRAME();
        moe_table(F, tb);
        MoeSched S; S.A = (const char*)(ws + WS_P); S.Bt = (const char*)(ws + WS_WD); S.list = (const int*)(ws + WS_LIST); S.tb = tb; S.K = 512; S.NT = 4; S.RG = 8; S.bid = F.bid;
        S.bstride = (size_t)1024 * 1024; S.gather = false;
        EpiDown E{ws + WS_DELTA, F.in[I_BD], (const int*)(ws + WS_LIST), tb};
        pg8::gemm_phase<EpiDown, MoeSched, true>(F.lds, F.tid, 512, S, E, E8_W, E8_ACT);
    }
    SEAM(9);
    REP(10) if (IN(10)) { if (rep_) xcd_barrier(bar, T0()); FRAME(); p10_final(F); }
#undef IN
#undef SEAM
}

extern "C" void kernel_launch(void* const* d_in, const int* in_sizes, int n_in, void* d_out, int out_size, void* d_ws, size_t ws_size, hipStream_t stream) {
    static int ready = 0;
    if (!ready) {
        if (n_in != 20 || out_size != T_ * D_ || ws_size < WS_END) { fprintf(stderr, "kernel_launch: unexpected shapes (n_in %d out %d ws %zu)\n", n_in, out_size, ws_size); ready = -1; return; }
        if (hipFuncSetAttribute((const void*)fwd, hipFuncAttributeMaxDynamicSharedMemorySize, LDS_BYTES) != hipSuccess) { fprintf(stderr, "kernel_launch: hipFuncSetAttribute failed\n"); ready = -1; return; }
        int per_cu = 0;
        if (hipOccupancyMaxActiveBlocksPerMultiprocessor(&per_cu, (const void*)fwd, 512, LDS_BYTES) != hipSuccess || per_cu < 1) fprintf(stderr, "kernel_launch: occupancy query says %d\n", per_cu);
        (void)hipGetLastError();
        ready = 1;
    }
    if (ready < 0) return;
    const int grid = 256;
    (void)hipMemsetAsync((char*)d_ws + WS_CTL, 0, CTL_BYTES, stream);
    Params p{};
    for (int i = 0; i < 20; ++i) p.in[i] = (const float*)d_in[i];
    p.out = (float*)d_out; p.ws = (unsigned char*)d_ws;
    if (N_LAUNCHES == 1) { p.ph_lo = 0; p.ph_hi = NPHASE; hipLaunchKernelGGL(fwd, dim3(grid), dim3(512), LDS_BYTES, stream, p); }
    else for (int k = 0; k < NPHASE; ++k) { p.ph_lo = k; p.ph_hi = k + 1; hipLaunchKernelGGL(fwd, dim3(grid), dim3(512), LDS_BYTES, stream, p); }
}
```

```cpp
#include <hip/hip_runtime.h>
#include <stdint.h>
#include <stdio.h>

#ifndef N_LAUNCHES
#define N_LAUNCHES 1
#endif

#define LAS __attribute__((address_space(3)))
typedef unsigned short bf16_t;
typedef short bf16x8 __attribute__((ext_vector_type(8)));
typedef float f32x4 __attribute__((ext_vector_type(4)));
typedef float f32x2 __attribute__((ext_vector_type(2)));
typedef unsigned u32x4 __attribute__((ext_vector_type(4)));
typedef unsigned u32x2 __attribute__((ext_vector_type(2)));
typedef __bf16 bfx2 __attribute__((ext_vector_type(2)));
#define DI __device__ __forceinline__

constexpr int T_ = 32768, D_ = 1024, L_ = 4096, NH = 8, NCH = 64;
constexpr int NP = 4608;
constexpr int PC_Q = 0, PC_K = 512, PC_V = 1024, PC_Z = 1536, PC_U = 2048, PC_GA = 2560, PC_GB = 3584;
constexpr int INW = 4624;
constexpr int NE = 32, LISTCAP = 32768;
constexpr int ACT_ROWS = 131072 + 8192;
constexpr float EPS = 1e-6f;
constexpr int NPHASE = 11;

constexpr size_t al256(size_t x) { return (x + 255) & ~(size_t)255; }
constexpr size_t WS_CTL = 0;
constexpr size_t CTL_BYTES = 65536;
constexpr size_t CW_BAR = 0;
constexpr size_t CW_CNT = 16384;
constexpr size_t WS_WIN = WS_CTL + CTL_BYTES;
constexpr size_t WS_WA = WS_WIN + (size_t)NP * 1024 * 2;
constexpr size_t WS_WB = WS_WA + (size_t)1024 * 512 * 2;
constexpr size_t WS_WOUT = WS_WB + (size_t)1024 * 512 * 2;
constexpr size_t WS_WGU = WS_WOUT + (size_t)1024 * 1024 * 2;
constexpr size_t WS_WD = WS_WGU + (size_t)NE * 2048 * 1024 * 2;
constexpr size_t WS_H = WS_WD + (size_t)NE * 1024 * 1024 * 2;
constexpr size_t WS_P = WS_H + (size_t)T_ * 1024 * 2;
constexpr size_t WS_DELTA = WS_P + (size_t)T_ * NP * 2;
DI int dl_cmajor(int unit) { return (unit & 63) * 64 + (unit >> 6); }
constexpr size_t DL_M = 0, DL_Q = (size_t)4096 * 8192, DL_S = 2 * DL_Q, DL_N = 3 * DL_Q, DL_O = DL_N + (size_t)4096 * 16384;
constexpr size_t WS_PM = WS_DELTA + (size_t)T_ * 4 * 1024 * 2;
constexpr size_t WS_OA = WS_PM + (size_t)T_ * 512 * 2;
constexpr size_t WS_TOPW = WS_OA + (size_t)T_ * 512 * 2;
constexpr size_t WS_LIST = WS_TOPW + (size_t)T_ * 4 * 4;
constexpr size_t WS_PARK = WS_LIST + (size_t)NE * LISTCAP * 4;
constexpr size_t WS_BA = WS_PARK + (size_t)2048 * 8192;
constexpr size_t WS_END = WS_BA + (size_t)T_ * 16 * 4;
static_assert(WS_END <= (size_t)1073741824, "workspace");
static_assert((size_t)ACT_ROWS * 1024 <= (size_t)T_ * NP * 2, "act (fp8) fits in p");

constexpr int LDS_BYTES = 163840;
constexpr int LDS_BARW = LDS_BYTES - 16;

DI unsigned pk_bf16(float lo, float hi) { bfx2 r = __builtin_convertvector((f32x2){lo, hi}, bfx2); return __builtin_bit_cast(unsigned, r); }
typedef int i32x8 __attribute__((ext_vector_type(8)));
typedef int i32x4 __attribute__((ext_vector_type(4)));
DI float clamp448(float x) { return fminf(fmaxf(x, -448.f), 448.f); }
DI unsigned pk4_fp8(float a, float b, float c, float d) {
    int w = 0; w = __builtin_amdgcn_cvt_pk_fp8_f32(clamp448(a), clamp448(b), w, false); w = __builtin_amdgcn_cvt_pk_fp8_f32(clamp448(c), clamp448(d), w, true); return (unsigned)w; }
constexpr float SC_H2 = 16.f, SC_ACT = 4.f, SC_W = 64.f, SC_Y = 16.f;
constexpr int E8_H2 = 0x7B7B7B7B, E8_ACT = 0x7D7D7D7D, E8_W = 0x79797979;
DI float bflo(unsigned u) { return __uint_as_float(u << 16); }
DI float bfhi(unsigned u) { return __uint_as_float(u & 0xffff0000u); }
DI float bf2f(unsigned short b) { return __uint_as_float(((unsigned)b) << 16); }
DI float fast_rcp(float x) { return __builtin_amdgcn_rcpf(x); }
DI float sigmoidf_(float x) { return fast_rcp(1.f + __expf(-x)); }
DI float siluf_(float x) { return x * sigmoidf_(x); }
DI float bperm(float v, int src_lane) { return __int_as_float(__builtin_amdgcn_ds_bpermute(src_lane << 2, __float_as_int(v))); }
DI void wsync() { asm volatile("s_waitcnt lgkmcnt(0)" ::: "memory"); }
DI float wave_sum(float v) {
#pragma unroll
    for (int m = 32; m >= 1; m >>= 1) v += __shfl_xor(v, m);
    return v;
}
DI float wave_sum_dpp(float v) {
    v += __uint_as_float(__builtin_amdgcn_update_dpp(0u, __float_as_uint(v), 0xB1, 0xf, 0xf, false));
    v += __uint_as_float(__builtin_amdgcn_update_dpp(0u, __float_as_uint(v), 0x4E, 0xf, 0xf, false));
    v += __uint_as_float(__builtin_amdgcn_update_dpp(0u, __float_as_uint(v), 0x141, 0xf, 0xf, false));
    v += __uint_as_float(__builtin_amdgcn_update_dpp(0u, __float_as_uint(v), 0x140, 0xf, 0xf, false));
    { const auto r = __builtin_amdgcn_permlane16_swap(__float_as_uint(v), __float_as_uint(v), false, false); v = __uint_as_float(r[0]) + __uint_as_float(r[1]); }
    { const auto r = __builtin_amdgcn_permlane32_swap(__float_as_uint(v), __float_as_uint(v), false, false); v = __uint_as_float(r[0]) + __uint_as_float(r[1]); }
    return v;
}
DI bf16x8 mk8(u32x2 lo, u32x2 hi) { u32x4 v = {lo.x, lo.y, hi.x, hi.y}; return __builtin_bit_cast(bf16x8, v); }
DI bf16x8 pack2(f32x4 a, f32x4 b) { u32x4 v = {pk_bf16(a[0], a[1]), pk_bf16(a[2], a[3]), pk_bf16(b[0], b[1]), pk_bf16(b[2], b[3])}; return __builtin_bit_cast(bf16x8, v); }
DI f32x4 mfma16(bf16x8 a, bf16x8 b, f32x4 c) { return __builtin_amdgcn_mfma_f32_16x16x32_bf16(a, b, c, 0, 0, 0); }

#define XB_TMO      128
#define XB_XCNT(j)  (256  + 64 * (j))
#define XB_XSUB(j)  (1280 + 64 * (j))
#define XB_XGEN(j)  (2304 + 64 * (j))
#define XB_TOP      3328
#define XB_TOPGEN   3392
#define XCD_BAR_WORDS 3456
#define XB_SPIN_CAP (1u << 18)
DI unsigned xb_ld(unsigned* p)              { return __hip_atomic_load(p, __ATOMIC_RELAXED, __HIP_MEMORY_SCOPE_AGENT); }
DI unsigned xb_add(unsigned* p, unsigned v) { return __hip_atomic_fetch_add(p, v, __ATOMIC_RELAXED, __HIP_MEMORY_SCOPE_AGENT); }
DI unsigned xb_xcc_id() { return (unsigned)__builtin_amdgcn_s_getreg((3 << 11) | 20) & 0xFu; }
#define XB_SPIN(cond, bar) do { unsigned _sp = 0; while (cond) { __builtin_amdgcn_s_sleep(1); \
    if ((++_sp & 255u) == 0u) { if (xb_ld(&(bar)[XB_TMO])) break; if (_sp > XB_SPIN_CAP) { atomicAdd(&(bar)[XB_TMO], 1u); break; } } } } while (0)
struct XcdBarrier { unsigned* bar; unsigned x; volatile LAS unsigned* st; };
DI XcdBarrier xcd_barrier_post(unsigned* bar, volatile LAS unsigned* st, bool t0) {
    XcdBarrier b; b.bar = bar; b.x = xb_xcc_id(); b.st = st;
    if (t0) (void)xb_add(&bar[XB_XCNT(b.x)], 1u);
    return b;
}
DI void xcd_barrier_complete(unsigned* bar, unsigned x, unsigned& nloc, unsigned& nx) {
    const unsigned G = gridDim.x * gridDim.y * gridDim.z;
    unsigned sum, cnt, mine, sp = 0u;
    for (;;) {
        sum = 0u; cnt = 0u; mine = 0u;
#pragma unroll
        for (unsigned j = 0; j < 16; ++j) { const unsigned c = xb_ld(&bar[XB_XCNT(j)]); sum += c; cnt += (c > 0u) ? 1u : 0u; mine = (j == x) ? c : mine; }
        if (sum == G) break;
        __builtin_amdgcn_s_sleep(1);
        if ((++sp & 255u) == 0u) { if (xb_ld(&bar[XB_TMO])) break; if (sp > XB_SPIN_CAP) { atomicAdd(&bar[XB_TMO], 1u); break; } }
    }
    nloc = mine > 0u ? mine : 1u; nx = cnt > 0u ? cnt : 1u;
}
DI void xcd_barrier(const XcdBarrier& b, bool t0) {
    asm volatile("s_waitcnt vmcnt(0)" ::: "memory");
    __syncthreads();
    if (t0) {
        unsigned* bar = b.bar;
        __builtin_amdgcn_s_waitcnt(0);
        unsigned nloc = b.st[0], nx = b.st[1];
        if (nloc == 0u) { xcd_barrier_complete(bar, b.x, nloc, nx); b.st[0] = nloc; b.st[1] = nx; }
        const unsigned old = xb_add(&bar[XB_XSUB(b.x)], 1u);
        const unsigned gen = old / nloc;
        if (old + 1u == (gen + 1u) * nloc) {
            __builtin_amdgcn_fence(__ATOMIC_RELEASE, "agent");
            asm volatile("s_waitcnt vmcnt(0)" ::: "memory");
            const unsigned og = xb_add(&bar[XB_TOP], 1u);
            const unsigned tg = og / nx;
            if (og + 1u == (tg + 1u) * nx) xb_add(&bar[XB_TOPGEN], 1u);
            else XB_SPIN(xb_ld(&bar[XB_TOPGEN]) == tg, bar);
            __builtin_amdgcn_fence(__ATOMIC_ACQUIRE, "agent");
            xb_add(&bar[XB_XGEN(b.x)], 1u);
            asm volatile("s_waitcnt vmcnt(0)" ::: "memory");
        } else {
            XB_SPIN(xb_ld(&bar[XB_XGEN(b.x)]) == gen, bar);
            __builtin_amdgcn_fence(__ATOMIC_ACQUIRE, "agent");
            asm volatile("s_waitcnt vmcnt(0)" ::: "memory");
        }
    }
    __syncthreads();
}

namespace pg8 {
constexpr int BM = 256, BK = 64, HALF = 128, HTB = HALF * BK * 2, STAGE_BYTES = 8 * HTB, NXCD = 8, WGM = 8;
__host__ __device__ __forceinline__ int lds_byte(int r, int c) { const int st = (r >> 4) * 2 + (c >> 5), rr = r & 15, cc = c & 31, ob = rr * 64 + cc * 2; return st * 1024 + (ob ^ (((ob >> 9) & 1) << 5)); }
__host__ __device__ __forceinline__ void stage_rc(int b, int& R, int& C) { const int st = b / 1024, sb = b % 1024, swz = sb ^ (((sb >> 9) & 1) << 5); R = (st >> 1) * 16 + swz / 64; C = (st & 1) * 32 + (swz % 64) / 2; }
__host__ __device__ __forceinline__ int perm32(int rho) { const int n = rho >> 4, i = rho & 15; return 8 * (i >> 2) + 4 * n + (i & 3); }

struct Unit { int pm, pn, e; };

struct StaticOrder {
    int nM, nN, nwg, G, c;
    DI void init(int M, int N, int G_, int c_) { nM = M / BM; nN = N / BM; nwg = nM * nN; G = G_; c = c_; }
    DI bool next(int i, Unit& u) const {
        const long L = (long)i * G + c; if (L >= nwg) return false;
        int wgid = (int)L; { const int q = nwg / NXCD, r = nwg % NXCD, xcd = wgid % NXCD, off = wgid / NXCD; wgid = (xcd < r ? xcd * (q + 1) : r * (q + 1) + (xcd - r) * q) + off; }
        const int nig = WGM * nN, gid = wgid / nig, fm = gid * WGM, gsz = (nM - fm) < WGM ? (nM - fm) : WGM;
        u.pm = fm + ((wgid % nig) % gsz); u.pn = (wgid % nig) / gsz; u.e = 0; return true;
    }
};

template <bool FP8> struct FragT { typedef bf16x8 type; };
template <> struct FragT<true> { typedef i32x8 type; };
template <class Epi, class Sched, bool FP8 = false>
DI void gemm_phase(LAS unsigned char* lds, const int tid, const int K, const Sched& S, const Epi& E, const int sclW = 0, const int sclA = 0) {
    const int wid = __builtin_amdgcn_readfirstlane(tid >> 6), lane = tid & 63, wr = wid >> 2, wc = wid & 3, fr = lane & 15, fq = lane >> 4;
    const int nt = K / BK;
    int R0, C0; stage_rc(tid * 16, R0, C0);
    const int Rb0 = Epi::PERM ? ((R0 & ~31) + perm32(R0 & 31)) : R0;
    unsigned voffB[2]; voffB[0] = (unsigned)(Rb0 * K + C0) * 2u; voffB[1] = (unsigned)((Rb0 + 64) * K + C0) * 2u;
    const size_t kstep = (size_t)(BK * 2);
    const size_t hstep = (size_t)HALF * K * 2;
    const unsigned ldsw = (unsigned)wid * 1024u;
    const int aoff = lds_byte(wr * 64 + fr, fq * 8), boff = lds_byte(wc * 32 + fr, fq * 8);
#define PG8_SA(b, h) (((b) * 2 + (h)) * HTB)
#define PG8_SB(b, h) ((4 + (b) * 2 + (h)) * HTB)
#define PG8_STAGE(bufoff, gbase, voff) do { _Pragma("unroll") for (int _i = 0; _i < 2; ++_i) \
        __builtin_amdgcn_global_load_lds((const unsigned*)((const char*)(gbase) + (voff)[_i]), (LAS unsigned*)(lds + (bufoff) + ldsw + _i * 8192), 16, 0, 0); } while (0)
#define PG8_LD2(p) __builtin_shufflevector(*(const LAS i32x4*)(p), *(const LAS i32x4*)((p) + 1024), 0, 1, 2, 3, 4, 5, 6, 7)
#define PG8_LDA(dst, b, h) do { _Pragma("unroll") for (int m = 0; m < 4; ++m) { if constexpr (FP8) dst[m][0] = __builtin_bit_cast(frag_t, PG8_LD2(lds + PG8_SA(b, h) + aoff + m * 2048)); \
        else { _Pragma("unroll") for (int k = 0; k < 2; ++k) dst[m][k] = __builtin_bit_cast(frag_t, *(const LAS bf16x8*)(lds + PG8_SA(b, h) + aoff + m * 2048 + k * 1024)); } } } while (0)
#define PG8_LDB(dst, b, h) do { _Pragma("unroll") for (int n = 0; n < 2; ++n) { if constexpr (FP8) dst[n][0] = __builtin_bit_cast(frag_t, PG8_LD2(lds + PG8_SB(b, h) + boff + n * 2048)); \
        else { _Pragma("unroll") for (int k = 0; k < 2; ++k) dst[n][k] = __builtin_bit_cast(frag_t, *(const LAS bf16x8*)(lds + PG8_SB(b, h) + boff + n * 2048 + k * 1024)); } } } while (0)
#define PG8_MMA(ai, bj, At, Bt) do { __builtin_amdgcn_s_setprio(1); _Pragma("unroll") for (int m = 0; m < 4; ++m) _Pragma("unroll") for (int n = 0; n < 2; ++n) { \
        if constexpr (FP8) asm volatile("v_mfma_scale_f32_16x16x128_f8f6f4 %0, %1, %2, %0, %3, %4 op_sel_hi:[0,0,0]" : "+v"(acc[ai][bj][m][n]) : "v"(Bt[n][0]), "v"(At[m][0]), "v"(sclW), "v"(sclA)); \
        else { _Pragma("unroll") for (int k = 0; k < 2; ++k) acc[ai][bj][m][n] = __builtin_amdgcn_mfma_f32_16x16x32_bf16(__builtin_bit_cast(bf16x8, Bt[n][k]), __builtin_bit_cast(bf16x8, At[m][k]), acc[ai][bj][m][n], 0, 0, 0); } } \
        __builtin_amdgcn_s_setprio(0); } while (0)
#define PG8_WAIT_V(n) asm volatile("s_waitcnt vmcnt(" #n ")" ::: "memory")
#define PG8_WAIT_L(n) asm volatile("s_waitcnt lgkmcnt(" #n ")" ::: "memory")
#define PG8_BAR __builtin_amdgcn_s_barrier()
#define PG8_SCHED __builtin_amdgcn_sched_barrier(0)
    Unit cur, nxt; int ui = 0;
    if (!S.next(0, cur)) return;
    f32x4 acc[2][2][4][2];
#pragma unroll
    for (int a = 0; a < 2; ++a)
#pragma unroll
        for (int b = 0; b < 2; ++b)
#pragma unroll
            for (int m = 0; m < 4; ++m)
#pragma unroll
                for (int n = 0; n < 2; ++n) acc[a][b][m][n] = (f32x4){0.f, 0.f, 0.f, 0.f};
    typedef typename FragT<FP8>::type frag_t;
    frag_t At[4][FP8 ? 1 : 2], B0[2][FP8 ? 1 : 2], B1[2][FP8 ? 1 : 2];
    unsigned ca[2][2], na[2][2];
    S.a_offs(cur, R0, C0, ca);
    const char* cA = S.a_base(cur); const char* cB = S.b_tile(cur);
    PG8_STAGE(PG8_SB(0, 0), cB, voffB); PG8_STAGE(PG8_SB(0, 1), cB + hstep, voffB); PG8_STAGE(PG8_SA(0, 0), cA, ca[0]); PG8_STAGE(PG8_SA(0, 1), cA, ca[1]);
    if (wr == 1) PG8_BAR;
    PG8_WAIT_V(2); PG8_BAR;
    PG8_STAGE(PG8_SB(1, 0), cB + kstep, voffB); PG8_STAGE(PG8_SA(1, 0), cA + kstep, ca[0]); PG8_STAGE(PG8_SB(1, 1), cB + hstep + kstep, voffB);
    PG8_WAIT_V(6); PG8_BAR;
    for (;;) {
        const bool has_next = S.next(ui + 1, nxt);
        const char* nA = cA; const char* nB = cB;
#pragma unroll
        for (int h = 0; h < 2; ++h) { na[h][0] = ca[h][0]; na[h][1] = ca[h][1]; }
        if (has_next) { nA = S.a_base(nxt); nB = S.b_tile(nxt); S.a_offs(nxt, R0, C0, na); }
        for (int t = 0; t < nt; t += 2) {
            const bool last = (t == nt - 2);
            const char* a1 = cA + (size_t)(t + 1) * kstep;
            const char* a2 = last ? nA : cA + (size_t)(t + 2) * kstep; const char* b2 = last ? nB : cB + (size_t)(t + 2) * kstep;
            const char* a3 = a2 + kstep; const char* b3 = b2 + kstep;
            unsigned sa[2][2];
            if (last) {
#pragma unroll
                for (int h = 0; h < 2; ++h) { sa[h][0] = na[h][0]; sa[h][1] = na[h][1]; }
            } else {
#pragma unroll
                for (int h = 0; h < 2; ++h) { sa[h][0] = ca[h][0]; sa[h][1] = ca[h][1]; }
            }
            PG8_LDB(B0, 0, 0); PG8_LDB(B1, 0, 1); PG8_SCHED; PG8_LDA(At, 0, 0); PG8_STAGE(PG8_SA(1, 1), a1, ca[1]);
            PG8_WAIT_V(8); PG8_WAIT_L(0); PG8_BAR; PG8_MMA(0, 0, At, B0); PG8_MMA(0, 1, At, B1); PG8_BAR; PG8_SCHED;
            PG8_LDA(At, 0, 1); PG8_STAGE(PG8_SB(0, 0), b2, voffB); PG8_STAGE(PG8_SB(0, 1), b2 + hstep, voffB); PG8_STAGE(PG8_SA(0, 0), a2, sa[0]);
            PG8_WAIT_V(8); PG8_WAIT_L(0); PG8_BAR; PG8_MMA(1, 0, At, B0); PG8_MMA(1, 1, At, B1); PG8_BAR; PG8_SCHED;
            PG8_LDB(B0, 1, 0); PG8_LDB(B1, 1, 1); PG8_SCHED; PG8_LDA(At, 1, 0); PG8_STAGE(PG8_SA(0, 1), a2, sa[1]);
            PG8_WAIT_V(8); PG8_WAIT_L(0); PG8_BAR; PG8_MMA(0, 0, At, B0); PG8_MMA(0, 1, At, B1); PG8_BAR; PG8_SCHED;
            PG8_LDA(At, 1, 1); PG8_STAGE(PG8_SB(1, 0), b3, voffB); PG8_STAGE(PG8_SB(1, 1), b3 + hstep, voffB); PG8_STAGE(PG8_SA(1, 0), a3, sa[0]);
            PG8_WAIT_V(8); PG8_WAIT_L(0); PG8_BAR; PG8_MMA(1, 0, At, B0); PG8_MMA(1, 1, At, B1); PG8_BAR; PG8_SCHED;
        }
        if constexpr (FP8) asm volatile("s_nop 15\n\ts_nop 15" ::: "memory");
        if (wr == 0) PG8_BAR;
        const bool keep = E(acc, cur, wr, wc, fr, fq);
        if (!has_next) break;
        if (!keep) {
#pragma unroll
            for (int a = 0; a < 2; ++a)
#pragma unroll
                for (int b = 0; b < 2; ++b)
#pragma unroll
                    for (int m = 0; m < 4; ++m)
#pragma unroll
                        for (int n = 0; n < 2; ++n) acc[a][b][m][n] = (f32x4){0.f, 0.f, 0.f, 0.f};
        }
        cur = nxt; cA = nA; cB = nB; ++ui;
#pragma unroll
        for (int h = 0; h < 2; ++h) { ca[h][0] = na[h][0]; ca[h][1] = na[h][1]; }
        if (wr == 1) PG8_BAR;
    }
    PG8_WAIT_V(0);
    PG8_BAR;
#undef PG8_SA
#undef PG8_SB
#undef PG8_STAGE
#undef PG8_LDA
#undef PG8_LDB
#undef PG8_MMA
#undef PG8_LD2
#undef PG8_WAIT_V
#undef PG8_WAIT_L
#undef PG8_BAR
#undef PG8_SCHED
}
}
using pg8::Unit;

struct Params { const float* in[20]; float* out; unsigned char* ws; int ph_lo, ph_hi; };
enum { I_X = 0, I_GMIX, I_WIN, I_CONVW, I_ALOG, I_DTB, I_DNN, I_WUPA, I_POOLW, I_POOLS, I_WUPB, I_WOUT, I_GFFN, I_WR, I_BR, I_WGU, I_BGU, I_WD, I_BD, I_GFIN };

struct Frame {
    LAS unsigned char* lds; int tid, lane, wid, G, bid;
    const float* in[20]; float* out; unsigned char* ws;
};

struct DenseSched {
    const char* A; const char* Bt; int K; pg8::StaticOrder so; int mixgate;
    DI bool next(int i, Unit& u) const { const bool ok = so.next(i, u); if (mixgate) { const int s = u.pn; u.pn = s >= 16 ? s - 8 : ((s & 1) ? 10 + (s >> 1) : (s >> 1)); } return ok; }
    DI const char* a_base(const Unit&) const { return A; }
    DI const char* b_tile(const Unit& u) const { return Bt + (size_t)u.pn * 256 * K * 2; }
    DI void a_offs(const Unit& u, int R0, int C0, unsigned (&o)[2][2]) const {
#pragma unroll
        for (int h = 0; h < 2; ++h)
#pragma unroll
            for (int i = 0; i < 2; ++i) o[h][i] = (unsigned)((u.pm * 256 + h * 128 + R0 + 64 * i) * K + C0) * 2u;
    }
};
struct UpSched {
    const char* A0; const char* A1; const char* B0; const char* B1; pg8::StaticOrder so;
    DI bool next(int i, Unit& u) const { const bool ok = so.next(i >> 1, u); u.e = i & 1; return ok; }
    DI const char* a_base(const Unit& u) const { return u.e ? A1 : A0; }
    DI const char* b_tile(const Unit& u) const { return (u.e ? B1 : B0) + (size_t)u.pn * 256 * 512 * 2; }
    DI void a_offs(const Unit& u, int R0, int C0, unsigned (&o)[2][2]) const {
#pragma unroll
        for (int h = 0; h < 2; ++h)
#pragma unroll
            for (int i = 0; i < 2; ++i) o[h][i] = (unsigned)((u.pm * 256 + h * 128 + R0 + 64 * i) * 512 + C0) * 2u;
    }
};
struct MoeTbl { int rts[NE + 1]; int cnt[NE]; };
struct MoeSched {
    const char* A; const char* Bt; const int* list; const LAS MoeTbl* tb; int K, NT  , RG  , bid; size_t bstride; bool gather;
    DI bool next(int i, Unit& u) const {
        const int xcd = bid & 7, j = bid >> 3;
        const int rt = RG * (i * 8 + xcd) + j / NT;
        if (rt >= tb->rts[NE]) return false;
        int e = 0;
        for (int q = 1; q < NE; ++q) e += (tb->rts[q] <= rt) ? 1 : 0;
        u.pm = rt; u.pn = j % NT; u.e = e; return true;
    }
    DI const char* a_base(const Unit&) const { return A; }
    DI const char* b_tile(const Unit& u) const { return Bt + (size_t)u.e * bstride + (size_t)u.pn * 256 * K * 2; }
    DI void a_offs(const Unit& u, int R0, int C0, unsigned (&o)[2][2]) const {
        const int lr0 = (u.pm - tb->rts[u.e]) * 256, cnt = tb->cnt[u.e];
#pragma unroll
        for (int h = 0; h < 2; ++h)
#pragma unroll
            for (int i = 0; i < 2; ++i) {
                const int r = h * 128 + R0 + 64 * i;
                int row;
                if (gather) { const int idx = lr0 + r; row = list[u.e * LISTCAP + (idx < cnt ? idx : cnt - 1)] >> 2; }
                else row = u.pm * 256 + r;
                o[h][i] = (unsigned)(row * K + C0) * 2u;
            }
    }
};

template <int K> DI float ubf(unsigned w) { float r; if (K == 0) asm("v_cvt_f32_ubyte0 %0, %1" : "=v"(r) : "v"(w)); else if (K == 1) asm("v_cvt_f32_ubyte1 %0, %1" : "=v"(r) : "v"(w)); else if (K == 2) asm("v_cvt_f32_ubyte2 %0, %1" : "=v"(r) : "v"(w)); else asm("v_cvt_f32_ubyte3 %0, %1" : "=v"(r) : "v"(w)); return r; }
struct EpiStoreBf16 {
    static constexpr bool PERM = true;
    bf16_t* O; int ldc;
    DI bool operator()(f32x4 (&acc)[2][2][4][2], const Unit& u, int wr, int wc, int fr, int fq) const {
        const int row0 = u.pm * 256 + wr * 64 + fr, col0 = u.pn * 256 + wc * 32 + 8 * fq;
#pragma unroll
        for (int ai = 0; ai < 2; ++ai)
#pragma unroll
            for (int m = 0; m < 4; ++m) { bf16_t* rowp = O + (size_t)(row0 + ai * 128 + m * 16) * ldc + col0;
#pragma unroll
                for (int bj = 0; bj < 2; ++bj) { const f32x4 v0 = acc[ai][bj][m][0], v1 = acc[ai][bj][m][1];
                    u32x4 w; w.x = pk_bf16(v0[0], v0[1]); w.y = pk_bf16(v0[2], v0[3]); w.z = pk_bf16(v1[0], v1[1]); w.w = pk_bf16(v1[2], v1[3]);
                    *(u32x4*)(rowp + bj * 128) = w; } }
        return false;
    }
};
struct EpiP {
    static constexpr bool PERM = true;
    bf16_t* O;
    DI bool operator()(f32x4 (&acc)[2][2][4][2], const Unit& u, int wr, int wc, int fr, int fq) const {
        const int row0 = u.pm * 256 + wr * 64 + fr;
        const bool gate = u.pn >= 10;
        const int colA = gate ? PC_GA + (u.pn - 10) * 128 + wc * 32 + 8 * fq : u.pn * 256 + wc * 32 + 8 * fq;
        const int colB = gate ? PC_GB + (u.pn - 10) * 128 + wc * 32 + 8 * fq : colA + 128;
#pragma unroll
        for (int ai = 0; ai < 2; ++ai)
#pragma unroll
            for (int m = 0; m < 4; ++m) { bf16_t* rowp = O + (size_t)(row0 + ai * 128 + m * 16) * NP;
                float a[8], b[8];
#pragma unroll
                for (int j = 0; j < 8; ++j) { a[j] = acc[ai][0][m][j >> 2][j & 3]; b[j] = acc[ai][1][m][j >> 2][j & 3]; }
                if (gate) {
                    u32x4 w = {0u, 0u, 0u, 0u};
#pragma unroll
                    for (int j = 0; j < 8; ++j) { const float sa = fast_rcp(1.f + __expf(-a[j])), sb = fast_rcp(1.f + __expf(-b[j]));
                        const float qa = __builtin_rintf(sa * 255.f), qb = fmaxf(__builtin_rintf(sb * 255.f), 1.f);
                        if (j < 4) { w.x = __builtin_amdgcn_cvt_pk_u8_f32(qa, j & 3, w.x); w.z = __builtin_amdgcn_cvt_pk_u8_f32(qb, j & 3, w.z); }
                        else { w.y = __builtin_amdgcn_cvt_pk_u8_f32(qa, j & 3, w.y); w.w = __builtin_amdgcn_cvt_pk_u8_f32(qb, j & 3, w.w); } }
                    __builtin_nontemporal_store(w, (u32x4*)((unsigned char*)rowp + PC_GA * 2 + (((u.pn - 10) * 16 + wc * 4 + fq) * 16)));
                    continue;
                }
                u32x4 w; w.x = pk_bf16(a[0], a[1]); w.y = pk_bf16(a[2], a[3]); w.z = pk_bf16(a[4], a[5]); w.w = pk_bf16(a[6], a[7]);
                __builtin_nontemporal_store(w, (u32x4*)(rowp + colA));
                w.x = pk_bf16(b[0], b[1]); w.y = pk_bf16(b[2], b[3]); w.z = pk_bf16(b[4], b[5]); w.w = pk_bf16(b[6], b[7]);
                __builtin_nontemporal_store(w, (u32x4*)(rowp + colB)); }
        return false;
    }
};
struct EpiUp {
    static constexpr bool PERM = true;
    const bf16_t* P; bf16_t* O;
    DI bool operator()(f32x4 (&acc)[2][2][4][2], const Unit& u, int wr, int wc, int fr, int fq) const {
        const int row0 = u.pm * 256 + wr * 64 + fr, col0 = u.pn * 256 + wc * 32 + 8 * fq;
        const unsigned char* G = (const unsigned char*)P + PC_GA * 2 + (u.pn * 32 + wc * 4 + fq) * 16;
#pragma unroll
        for (int ai = 0; ai < 2; ++ai) {
            u32x4 gv[4][2];
#pragma unroll
            for (int m = 0; m < 4; ++m)
#pragma unroll
                for (int bj = 0; bj < 2; ++bj) gv[m][bj] = *(const u32x4*)(G + (size_t)(row0 + ai * 128 + m * 16) * (NP * 2) + bj * 256);
#pragma unroll
            for (int m = 0; m < 4; ++m) { const size_t row = (size_t)(row0 + ai * 128 + m * 16);
#pragma unroll
                for (int bj = 0; bj < 2; ++bj) {
                    const u32x4 g4 = gv[m][bj];
                    const float qb8[8] = {ubf<0>(g4.z), ubf<1>(g4.z), ubf<2>(g4.z), ubf<3>(g4.z), ubf<0>(g4.w), ubf<1>(g4.w), ubf<2>(g4.w), ubf<3>(g4.w)};
                    if (u.e == 0) {
                        const float qa8[8] = {ubf<0>(g4.x), ubf<1>(g4.x), ubf<2>(g4.x), ubf<3>(g4.x), ubf<0>(g4.y), ubf<1>(g4.y), ubf<2>(g4.y), ubf<3>(g4.y)};
#pragma unroll
                        for (int j = 0; j < 8; ++j) acc[ai][bj][m][j >> 2][j & 3] *= qa8[j] * fast_rcp(qb8[j]);
                    } else {
                        float o[8];
#pragma unroll
                        for (int j = 0; j < 8; ++j) o[j] = acc[ai][bj][m][j >> 2][j & 3] * (qb8[j] * (1.f / 255.f));
                        u32x4 w; w.x = pk_bf16(o[0], o[1]); w.y = pk_bf16(o[2], o[3]); w.z = pk_bf16(o[4], o[5]); w.w = pk_bf16(o[6], o[7]);
                        *(u32x4*)(O + row * 1024 + col0 + bj * 128) = w;
                    } } }
            asm volatile("" ::: "memory");
        }
        return u.e == 0;
    }
};
struct EpiResid {
    static constexpr bool PERM = false;
    const float* X; float* O;
    DI bool operator()(f32x4 (&acc)[2][2][4][2], const Unit& u, int wr, int wc, int fr, int fq) const {
        const int row0 = u.pm * 256 + wr * 64 + fr, col0 = u.pn * 256 + wc * 32 + 4 * fq;
#pragma unroll
        for (int ai = 0; ai < 2; ++ai)
#pragma unroll
            for (int m = 0; m < 4; ++m) { const size_t ro = (size_t)(row0 + ai * 128 + m * 16) * 1024 + col0;
#pragma unroll
                for (int bj = 0; bj < 2; ++bj)
#pragma unroll
                    for (int n = 0; n < 2; ++n) { const f32x4 xv = *(const f32x4*)(X + ro + bj * 128 + n * 16); *(f32x4*)(O + ro + bj * 128 + n * 16) = acc[ai][bj][m][n] + xv; } }
        return false;
    }
};
struct EpiGateUp {
    static constexpr bool PERM = true;
    unsigned char* ACT; const float* bgu;
    DI bool operator()(f32x4 (&acc)[2][2][4][2], const Unit& u, int wr, int wc, int fr, int fq) const {
        const int row0 = u.pm * 256 + wr * 64 + fr, c0 = u.pn * 128 + wc * 32 + 8 * fq;
        const float* bg = bgu + (size_t)u.e * 2048 + c0;
        f32x2 bgv[4], buv[4];
#pragma unroll
        for (int q = 0; q < 4; ++q) { bgv[q] = *(const f32x2*)(bg + 2 * q); buv[q] = *(const f32x2*)(bg + 1024 + 2 * q); }
#pragma unroll
        for (int ai = 0; ai < 2; ++ai)
#pragma unroll
            for (int m = 0; m < 4; ++m) {
                f32x2 o[4];
#pragma unroll
                for (int q = 0; q < 4; ++q) {
                    f32x2 gt = (f32x2){acc[ai][0][m][q >> 1][2 * (q & 1)], acc[ai][0][m][q >> 1][2 * (q & 1) + 1]} + bgv[q];
                    f32x2 up = (f32x2){acc[ai][1][m][q >> 1][2 * (q & 1)], acc[ai][1][m][q >> 1][2 * (q & 1) + 1]} + buv[q];
                    gt.x = fminf(gt.x, 7.f); gt.y = fminf(gt.y, 7.f);
                    up.x = __builtin_amdgcn_fmed3f(up.x, -7.f, 7.f); up.y = __builtin_amdgcn_fmed3f(up.y, -7.f, 7.f);
                    const f32x2 ex = gt * (-1.702f * 1.44269504f);
                    f32x2 den; den.x = __builtin_amdgcn_exp2f(ex.x); den.y = __builtin_amdgcn_exp2f(ex.y);
                    den = den + 1.f;
                    f32x2 sg; sg.x = fast_rcp(den.x); sg.y = fast_rcp(den.y);
                    o[q] = (gt * sg) * (up * SC_ACT + SC_ACT);
                }
                u32x2 w;
                { int t = 0; t = __builtin_amdgcn_cvt_pk_fp8_f32(o[0].x, o[0].y, t, false); t = __builtin_amdgcn_cvt_pk_fp8_f32(o[1].x, o[1].y, t, true); w.x = (unsigned)t; }
                { int t = 0; t = __builtin_amdgcn_cvt_pk_fp8_f32(o[2].x, o[2].y, t, false); t = __builtin_amdgcn_cvt_pk_fp8_f32(o[3].x, o[3].y, t, true); w.y = (unsigned)t; }
                *(u32x2*)(ACT + (size_t)(row0 + ai * 128 + m * 16) * 1024 + c0) = w;
            }
        return false;
    }
};
struct EpiDown {
    static constexpr bool PERM = true;
    unsigned char* YK; const float* bd; const int* list; const LAS MoeTbl* tb;
    DI bool operator()(f32x4 (&acc)[2][2][4][2], const Unit& u, int wr, int wc, int fr, int fq) const {
        const int lr0 = (u.pm - tb->rts[u.e]) * 256 + wr * 64 + fr, cnt = tb->cnt[u.e], col0 = u.pn * 256 + wc * 32 + 8 * fq;
        const float* b = bd + (size_t)u.e * 1024 + col0;
        f32x4 bv[2][2];
#pragma unroll
        for (int bj = 0; bj < 2; ++bj) { bv[bj][0] = *(const f32x4*)(b + bj * 128); bv[bj][1] = *(const f32x4*)(b + bj * 128 + 4); }
        int dst[2][4];
#pragma unroll
        for (int ai = 0; ai < 2; ++ai)
#pragma unroll
            for (int m = 0; m < 4; ++m) { const int idx = lr0 + ai * 128 + m * 16; const int d = list[u.e * LISTCAP + (idx < cnt ? idx : cnt - 1)]; dst[ai][m] = (idx < cnt) ? d : 4 * T_; }
#pragma unroll
        for (int ai = 0; ai < 2; ++ai)
#pragma unroll
            for (int m = 0; m < 4; ++m) {
                unsigned char* rowp = YK + (size_t)dst[ai][m] * 1024 + col0;
#pragma unroll
                for (int bj = 0; bj < 2; ++bj) { const f32x4 v0 = (acc[ai][bj][m][0] + bv[bj][0]) * SC_Y, v1 = (acc[ai][bj][m][1] + bv[bj][1]) * SC_Y;
                    u32x2 w; w.x = pk4_fp8(v0[0], v0[1], v0[2], v0[3]); w.y = pk4_fp8(v1[0], v1[1], v1[2], v1[3]);
                    *(u32x2*)(rowp + bj * 128) = w; }
            }
        return false;
    }
};

template <class CM>
DI void transpose_tile(const Frame& F, const float* src, int ldsrc, bf16_t* dst, int K, int k0, int n0, CM cm) {
    LAS float* tile = (LAS float*)F.lds;
    const int r = F.tid >> 4, c4 = (F.tid & 15) * 4;
    const int col0 = cm(n0 + c4);
#pragma unroll
    for (int pass = 0; pass < 2; ++pass) {
        const int rr = r + 32 * pass;
        f32x4 v = {0.f, 0.f, 0.f, 0.f};
        if (col0 >= 0) v = *(const f32x4*)(src + (size_t)(k0 + rr) * ldsrc + col0);
#pragma unroll
        for (int e = 0; e < 4; ++e) tile[rr * 65 + c4 + e] = v[e];
    }
    __syncthreads();
    const int n = F.tid >> 3, k8 = (F.tid & 7) * 8;
    float x[8];
#pragma unroll
    for (int e = 0; e < 8; ++e) x[e] = tile[(k8 + e) * 65 + n];
    u32x4 w; w.x = pk_bf16(x[0], x[1]); w.y = pk_bf16(x[2], x[3]); w.z = pk_bf16(x[4], x[5]); w.w = pk_bf16(x[6], x[7]);
    *(u32x4*)(dst + (size_t)(n0 + n) * K + k0 + k8) = w;
    __syncthreads();
}
struct BigTile { const float* src; unsigned char* dst; int ldsrc, k0, n0, scol, dpitch, bf; };
DI int cm_win(int n) { if (n < 2560) return n < 2048 ? n : n + 16; const int t = (n - 2560) >> 8, j = (n - 2560) & 255; return j < 128 ? 2576 + 128 * t + j : 3600 + 128 * t + (j - 128); }
DI void bt_load(const BigTile& t, int tid, f32x4 (&v)[8]) {
    const int r = tid >> 5, c4 = (tid & 31) * 4;
#pragma unroll
    for (int p = 0; p < 8; ++p) v[p] = *(const f32x4*)(t.src + (size_t)(t.k0 + r + 16 * p) * t.ldsrc + t.scol + c4);
}
DI void bt_store(const BigTile& t, LAS float* tile  , int tid, const f32x4 (&v)[8]) {
    const int r = tid >> 5, c4 = (tid & 31) * 4;
#pragma unroll
    for (int p = 0; p < 8; ++p) *(LAS f32x4*)(tile + (r + 16 * p) * 132 + c4) = v[p];
    __syncthreads();
    const int n = tid >> 2, kq = (tid & 3) * 32;
    float x[32];
#pragma unroll
    for (int e = 0; e < 32; ++e) x[e] = tile[(kq + e) * 132 + n];
    if (t.bf) {
        bf16_t* o = (bf16_t*)t.dst + (size_t)(t.n0 + n) * t.dpitch + t.k0 + kq;
#pragma unroll
        for (int q = 0; q < 4; ++q) { u32x4 w; w.x = pk_bf16(x[8 * q], x[8 * q + 1]); w.y = pk_bf16(x[8 * q + 2], x[8 * q + 3]); w.z = pk_bf16(x[8 * q + 4], x[8 * q + 5]); w.w = pk_bf16(x[8 * q + 6], x[8 * q + 7]);
            *(u32x4*)(o + 8 * q) = w; }
    } else {
        unsigned char* o = t.dst + (size_t)(t.n0 + n) * t.dpitch + t.k0 + kq;
#pragma unroll
        for (int q = 0; q < 2; ++q) { u32x4 w;
            w.x = pk4_fp8(x[16 * q] * SC_W, x[16 * q + 1] * SC_W, x[16 * q + 2] * SC_W, x[16 * q + 3] * SC_W); w.y = pk4_fp8(x[16 * q + 4] * SC_W, x[16 * q + 5] * SC_W, x[16 * q + 6] * SC_W, x[16 * q + 7] * SC_W);
            w.z = pk4_fp8(x[16 * q + 8] * SC_W, x[16 * q + 9] * SC_W, x[16 * q + 10] * SC_W, x[16 * q + 11] * SC_W); w.w = pk4_fp8(x[16 * q + 12] * SC_W, x[16 * q + 13] * SC_W, x[16 * q + 14] * SC_W, x[16 * q + 15] * SC_W);
            *(u32x4*)(o + 16 * q) = w; }
    }
    __syncthreads();
}
constexpr int NWT = 4096 + 2048 + 288 + 64 + 32;
DI BigTile moe_w_tile(const Frame& F, int i) {
    BigTile t; t.bf = 0; t.dpitch = 1024;
    if (i < 4096) { const int e = i >> 7, r = i & 127, sc = r & 15, nb = sc < 8 ? 2 * sc : 2 * (sc - 8) + 1;
        t.src = F.in[I_WGU] + (size_t)e * 1024 * 2048; t.dst = F.ws + WS_WGU + (size_t)e * 2048 * 1024; t.ldsrc = 2048; t.k0 = (r >> 4) * 128; t.n0 = nb * 128;
        t.scol = (nb & 1) ? 1024 + (nb >> 1) * 128 : (nb >> 1) * 128; }
    else if (i < 6144) { const int j = i - 4096, e = j >> 6, r = j & 63; t.src = F.in[I_WD] + (size_t)e * 1024 * 1024; t.dst = F.ws + WS_WD + (size_t)e * 1024 * 1024; t.ldsrc = 1024; t.k0 = (r >> 3) * 128; t.n0 = (r & 7) * 128; t.scol = t.n0; }
    else if (i < 6432) { const int j = i - 6144; t.bf = 1; t.src = F.in[I_WIN]; t.dst = F.ws + WS_WIN; t.ldsrc = INW; t.k0 = (j / 36) * 128; t.n0 = (j % 36) * 128; t.scol = cm_win(t.n0); }
    else if (i < 6496) { const int j = i - 6432; t.bf = 1; t.src = F.in[I_WOUT]; t.dst = F.ws + WS_WOUT; t.ldsrc = 1024; t.k0 = (j & 7) * 128; t.n0 = (j >> 3) * 128; t.scol = t.n0; }
    else { const int j = i - 6496; t.bf = 1; t.dpitch = 512; t.src = F.in[I_WUPA]; t.dst = F.ws + WS_WA; t.ldsrc = 1024; t.k0 = (j & 3) * 128; t.n0 = (j >> 2) * 128; t.scol = t.n0; }
    return t;
}
DI void moe_weights(const Frame& F, int rank, int nrank) {
    LAS float* tile = (LAS float*)F.lds;
    const int per = (NWT + nrank - 1) / nrank;
    f32x4 v[3][8];
#define MW_TILE(j) moe_w_tile(F, min(rank + (j) * nrank, NWT - 1))
    { const BigTile t0 = MW_TILE(0); bt_load(t0, F.tid, v[0]); const BigTile t1 = MW_TILE(1); bt_load(t1, F.tid, v[1]); const BigTile t2 = MW_TILE(2); bt_load(t2, F.tid, v[2]); }
    (void)per;
    const int mine = (NWT - rank + nrank - 1) / nrank;
    int j0 = 0;
    for (; j0 + 3 <= mine; j0 += 3) {
#pragma unroll
        for (int q = 0; q < 3; ++q) {
            const BigTile t = MW_TILE(j0 + q);
            bt_store(t, tile, F.tid, v[q]);
            const BigTile tn = MW_TILE(j0 + q + 3);
            bt_load(tn, F.tid, v[q]);
        }
    }
    if (j0 < mine) { const BigTile t = MW_TILE(j0); bt_store(t, tile, F.tid, v[0]); }
    if (j0 + 1 < mine) { const BigTile t = MW_TILE(j0 + 1); bt_store(t, tile, F.tid, v[1]); }
#undef MW_TILE
}
struct CmIdent { DI int operator()(int n) const { return n; } };
struct CmWin { DI int operator()(int n) const { if (n < 2560) return n < 2048 ? n : n + 16; const int t = (n - 2560) >> 8, j = (n - 2560) & 255; return j < 128 ? 2576 + 128 * t + j : 3600 + 128 * t + (j - 128); } };
struct CmGu { DI int operator()(int n) const { const int pn = n >> 8, j = n & 255; return j < 128 ? pn * 128 + j : 1024 + pn * 128 + (j - 128); } };

DI void p0_prologue(const Frame& F) {
    unsigned char* ws = F.ws;
    {
        LAS float* Bs = (LAS float*)F.lds;
        LAS float* Ps = Bs + 128 * 64;
        bf16_t* d = (bf16_t*)(ws + WS_WB);
        for (int u = F.bid; u < 4 * 16 * 4; u += F.G) {
            const int g = u >> 6, n0 = ((u >> 2) & 15) * 64, c0 = (u & 3) * 32;
            int tq = F.tid; asm volatile("" : "+v"(tq));
            {   f32x4 wb[4], wp[2]; float sc[4];
#pragma unroll
                for (int j = 0; j < 4; ++j) { const int i = tq + 512 * j, dd = i >> 4, q = i & 15; wb[j] = *(const f32x4*)(F.in[I_WUPB] + (size_t)(g * 128 + dd) * 1024 + n0 + 4 * q); sc[j] = F.in[I_POOLS][g * 128 + dd]; }
#pragma unroll
                for (int j = 0; j < 2; ++j) { const int i = tq + 512 * j, c = i >> 5, q = i & 31; wp[j] = *(const f32x4*)(F.in[I_POOLW] + (size_t)g * 128 * 128 + (size_t)(c0 + c) * 128 + 4 * q); }
#pragma unroll
                for (int j = 0; j < 4; ++j) { const int i = tq + 512 * j, dd = i >> 4, q = i & 15; *(LAS f32x4*)(Bs + dd * 64 + 4 * q) = wb[j] * sc[j]; }
#pragma unroll
                for (int j = 0; j < 2; ++j) { const int i = tq + 512 * j, c = i >> 5, q = i & 31; *(LAS f32x4*)(Ps + c * 128 + 4 * q) = wp[j]; } }
            __syncthreads();
            const int n = tq & 63, cw = (tq >> 6) * 4;
            float acc[4] = {0.f, 0.f, 0.f, 0.f};
#pragma unroll 1
            for (int d0 = 0; d0 < 128; d0 += 16) {
                float bq[16]; f32x4 pq[4][4];
#pragma unroll
                for (int j = 0; j < 16; ++j) bq[j] = Bs[(d0 + j) * 64 + n];
#pragma unroll
                for (int c = 0; c < 4; ++c)
#pragma unroll
                    for (int q = 0; q < 4; ++q) pq[c][q] = *(const LAS f32x4*)(Ps + (cw + c) * 128 + d0 + 4 * q);
                __builtin_amdgcn_sched_barrier(0);
#pragma unroll
                for (int c = 0; c < 4; ++c)
#pragma unroll
                    for (int q = 0; q < 4; ++q) acc[c] += pq[c][q][0] * bq[4 * q] + pq[c][q][1] * bq[4 * q + 1] + pq[c][q][2] * bq[4 * q + 2] + pq[c][q][3] * bq[4 * q + 3];
                __builtin_amdgcn_sched_barrier(0);
            }
            u32x2 w; w.x = pk_bf16(acc[0], acc[1]); w.y = pk_bf16(acc[2], acc[3]);
            *(u32x2*)(d + (size_t)(n0 + n) * 512 + g * 128 + c0 + cw) = w;
            __syncthreads();
        }
    }
    {
        const float* x = F.in[I_X]; const float* gm = F.in[I_GMIX]; bf16_t* hb = (bf16_t*)(ws + WS_H); float* BA = (float*)(ws + WS_BA);
        LAS float* W16 = (LAS float*)F.lds;
        __syncthreads();
        {   f32x4 w8[8];
#pragma unroll
            for (int j = 0; j < 8; ++j) { const int i = F.tid + 512 * j, k = i >> 2, q = i & 3; w8[j] = *(const f32x4*)(F.in[I_WIN] + (size_t)k * INW + 2048 + 4 * q); }
#pragma unroll
            for (int j = 0; j < 8; ++j) { const int i = F.tid + 512 * j, k = i >> 2, q = i & 3; *(LAS f32x4*)(W16 + ((k & 3) * 256 + (k >> 2)) * 20 + 4 * q) = w8[j]; } }
        __syncthreads();
        f32x4 g[4];
#pragma unroll
        for (int i = 0; i < 4; ++i) g[i] = *(const f32x4*)(gm + 4 * (F.lane + 64 * i));
        const int lane = F.lane;
        f32x4 vn[4][4];
#define RMS_LOAD(t0) do { _Pragma("unroll") for (int r = 0; r < 4; ++r) { const f32x4* xr = (const f32x4*)(x + (size_t)((t0) + r) * 1024); \
            _Pragma("unroll") for (int i = 0; i < 4; ++i) vn[r][i] = xr[lane + 64 * i]; } } while (0)
        RMS_LOAD((F.bid * 8 + F.wid) * 4);
        for (int tok0 = (F.bid * 8 + F.wid) * 4; tok0 < T_; tok0 += F.G * 8 * 4) {
            f32x4 v[4][4]; float rn[4];
#pragma unroll
            for (int r = 0; r < 4; ++r)
#pragma unroll
                for (int i = 0; i < 4; ++i) v[r][i] = vn[r][i];
            { const int tn = tok0 + F.G * 8 * 4; RMS_LOAD(tn < T_ ? tn : tok0); }
#pragma unroll
            for (int r = 0; r < 4; ++r) { float a = 0.f;
#pragma unroll
                for (int i = 0; i < 4; ++i) a += v[r][i][0] * v[r][i][0] + v[r][i][1] * v[r][i][1] + v[r][i][2] * v[r][i][2] + v[r][i][3] * v[r][i][3];
                rn[r] = __builtin_amdgcn_rsqf(wave_sum(a) * (1.f / 1024.f) + EPS); }
            float acc[4][16];
#pragma unroll
            for (int r = 0; r < 4; ++r)
#pragma unroll
                for (int j = 0; j < 16; ++j) acc[r][j] = 0.f;
#pragma unroll
            for (int i = 0; i < 4; ++i) {
#pragma unroll
                for (int r = 0; r < 4; ++r) { v[r][i] = v[r][i] * rn[r] * g[i];
                    u32x2 w; w.x = pk_bf16(v[r][i][0], v[r][i][1]); w.y = pk_bf16(v[r][i][2], v[r][i][3]);
                    *(u32x2*)(hb + (size_t)(tok0 + r) * 1024 + 4 * (lane + 64 * i)) = w; }
#pragma unroll
                for (int e = 0; e < 4; ++e) {
                    asm volatile("" ::: "memory");
                    const LAS float* wr = W16 + (e * 256 + i * 64 + lane) * 20;
#pragma unroll
                    for (int q = 0; q < 4; ++q) { const f32x4 wv = *(const LAS f32x4*)(wr + 4 * q);
#pragma unroll
                        for (int r = 0; r < 4; ++r)
#pragma unroll
                            for (int z = 0; z < 4; ++z) acc[r][4 * q + z] += v[r][i][e] * wv[z]; }
                }
            }
#define BA_STEP(mask, half) { const bool up = (lane & (mask)) != 0; _Pragma("unroll") for (int r = 0; r < 4; ++r) _Pragma("unroll") for (int j = 0; j < (half); ++j) { \
                const float keep = up ? acc[r][j + (half)] : acc[r][j], send = up ? acc[r][j] : acc[r][j + (half)]; acc[r][j] = keep + __shfl_xor(send, (mask)); } }
            BA_STEP(32, 8) BA_STEP(16, 4) BA_STEP(8, 2) BA_STEP(4, 1)
#undef BA_STEP
#pragma unroll
            for (int r = 0; r < 4; ++r) { float t = acc[r][0]; t += __shfl_xor(t, 1); t += __shfl_xor(t, 2);
                if ((lane & 3) == 0) BA[(size_t)(tok0 + r) * 16 + (lane >> 2)] = t; }
        }
#undef RMS_LOAD
    }
}

constexpr int DLD = 72;
constexpr int DW_X = 0, DW_Y = 9216, DW_ARR = 18432, DW_BYTES = 20352;
constexpr int at_mstart(int j) { return (j + 1) & ~3; }
constexpr int atl_base(int j) { const int a = j >> 2, b = j & 3; return 32 * j - 4 * (2 * a * (a - 1) + a * (b + 1)); }
constexpr int ATL_BLK = 544, BPP = 40, X_PT = 2 * ATL_BLK * 4, Y_T22 = 0, Y_T11T = 32 * BPP * 2, Y_Z = 2 * 32 * BPP * 2;
static_assert(atl_base(32) == ATL_BLK && X_PT + 32 * BPP * 2 <= 9216 && Y_Z + 32 * BPP * 2 <= 9216, "blocked solve LDS map");
constexpr int at_base(int j) { const int a = j >> 2, b = j & 3; return 64 * j - 4 * (2 * a * (a - 1) + a * (b + 1)); }

DI void conv_load(const bf16_t* P, long tok0, bool first_chunk, int pcol, int lane, u32x4 (&xin)[11]) {
    const int tg = lane >> 3, cg = lane & 7;
#pragma unroll
    for (int r = 0; r < 11; ++r) {
        const int tr = 8 * tg + r - 3;
        const bool ok = !(first_chunk && tr < 0);
        u32x4 v = {0u, 0u, 0u, 0u};
        if (ok) v = *(const u32x4*)(P + (size_t)(tok0 + tr) * NP + pcol + 8 * cg);
        xin[r] = v;
    }
}
template <int HALF>
DI void conv_half(const u32x4 (&xin)[11], const float* cw, int lane, float (&out)[4][8]) {
    const int cg = lane & 7;
    f32x4 w[4][2];
#pragma unroll
    for (int j = 0; j < 4; ++j) { w[j][0] = *(const f32x4*)(cw + j * 1536 + 8 * cg); w[j][1] = *(const f32x4*)(cw + j * 1536 + 8 * cg + 4); }
#pragma unroll
    for (int i = 0; i < 4; ++i) {
        float a[8];
#pragma unroll
        for (int e = 0; e < 8; ++e) a[e] = 0.f;
#pragma unroll
        for (int j = 0; j < 4; ++j) {
            const u32x4 x = xin[4 * HALF + i + j];
            const float xv[8] = {bflo(x.x), bfhi(x.x), bflo(x.y), bfhi(x.y), bflo(x.z), bfhi(x.z), bflo(x.w), bfhi(x.w)};
#pragma unroll
            for (int e = 0; e < 8; ++e) a[e] += w[j][e >> 2][e & 3] * xv[e];
        }
#pragma unroll
        for (int e = 0; e < 8; ++e) out[i][e] = siluf_(a[e]);
    }
}
DI void l2norm_half(const float (&v)[4][8], float scale, float (&rs)[4], int lane) {
#pragma unroll
    for (int i = 0; i < 4; ++i) {
        float ss = 0.f;
#pragma unroll
        for (int e = 0; e < 8; ++e) ss += v[i][e] * v[i][e];
        (void)lane;
        ss += __uint_as_float(__builtin_amdgcn_update_dpp(0u, __float_as_uint(ss), 0xB1, 0xf, 0xf, false));
        ss += __uint_as_float(__builtin_amdgcn_update_dpp(0u, __float_as_uint(ss), 0x4E, 0xf, 0xf, false));
        ss += __uint_as_float(__builtin_amdgcn_update_dpp(0u, __float_as_uint(ss), 0x141, 0xf, 0xf, false));
        rs[i] = __builtin_amdgcn_rsqf(ss + EPS) * scale;
    }
}
DI void write_rowmajor_h(LAS unsigned char* img, const float (&v)[4][8], const float (&rs)[4], int lane, int half) {
    const int tg = lane >> 3, cg = lane & 7;
#pragma unroll
    for (int i = 0; i < 4; ++i) { u32x4 w; w.x = pk_bf16(v[i][0] * rs[i], v[i][1] * rs[i]); w.y = pk_bf16(v[i][2] * rs[i], v[i][3] * rs[i]); w.z = pk_bf16(v[i][4] * rs[i], v[i][5] * rs[i]); w.w = pk_bf16(v[i][6] * rs[i], v[i][7] * rs[i]);
        *(LAS u32x4*)(img + ((8 * tg + 4 * half + i) * DLD + 8 * cg) * 2) = w; }
}
DI void write_transposed_h(LAS unsigned char* img, const float (&v)[4][8], const float (&rs)[4], int lane, int half) {
    const int tg = lane >> 3, cg = lane & 7;
#pragma unroll
    for (int e = 0; e < 8; ++e) { u32x2 w; w.x = pk_bf16(v[0][e] * rs[0], v[1][e] * rs[1]); w.y = pk_bf16(v[2][e] * rs[2], v[3][e] * rs[3]);
        *(LAS u32x2*)(img + ((8 * cg + e) * DLD + 8 * tg + 4 * half) * 2) = w; }
}
DI bf16x8 read_frag(const LAS unsigned char* img, int rt, int s, int fr, int g) {
    const LAS unsigned char* p = img + ((16 * rt + fr) * DLD + 32 * s + 4 * g) * 2;
    return mk8(*(const LAS u32x2*)p, *(const LAS u32x2*)(p + 32));
}

DI bf16x8 read_frag32(const LAS unsigned char* img, int rt, int fr, int g) {
    const LAS unsigned char* p = img + ((16 * rt + fr) * BPP + 4 * g) * 2;
    return mk8(*(const LAS u32x2*)p, *(const LAS u32x2*)(p + 32));
}
DI void delta_prep_unit(unsigned char* ws_, const float* convw, const float* alog, const float* dtb, int parkslot, LAS unsigned char* wl, int unit) {
#define SEC() int lane = threadIdx.x & 63; asm volatile("" : "+v"(lane)); const int fr = lane & 15, g = lane >> 4; (void)fr; (void)g; \
    u32x4* Mb = (u32x4*)(dl + DL_M) + (size_t)dl_cmajor(unit) * 8 * 64 + lane; u32x4* Qb = (u32x4*)(dl + DL_Q) + (size_t)unit * 8 * 64 + lane; \
    u32x2* Nb = (u32x2*)(dl + DL_N) + (size_t)dl_cmajor(unit) * 16 * 64 + lane; u32x2* Ob = (u32x2*)(dl + DL_O) + (size_t)unit * 16 * 64 + lane; \
    u32x4* Sbp = (u32x4*)(dl + DL_S) + (size_t)dl_cmajor(unit) * 8 * 64 + lane; u32x4* Kpark = (u32x4*)(ws_ + WS_PARK) + (size_t)parkslot * 8 * 64 + lane; \
    (void)Mb; (void)Qb; (void)Nb; (void)Ob; (void)Sbp; (void)Kpark;
    unsigned char* dl = ws_ + WS_DELTA;
    const int bh = unit >> 6, c = unit & 63, b = bh >> 3, h = bh & 7;
    const long tok0 = (long)b * L_ + c * 64;
    const bool first = (c == 0);
    const bf16_t* P = (const bf16_t*)(ws_ + WS_P);
    LAS unsigned char* X = wl + DW_X; LAS unsigned char* Y = wl + DW_Y;
    LAS float* sG = (LAS float*)(wl + DW_ARR); LAS float* sBeta = sG + 64; LAS float* sBE = sG + 128; LAS float* sEL = sG + 192; LAS float* sEG = sG + 256;
    const f32x4 z4 = {0.f, 0.f, 0.f, 0.f};
    u32x4 xk[11];
    { SEC(); conv_load(P, tok0, first, PC_K + h * 64, lane, xk); }
    float glast;
    {
        SEC();
        const float* BA = (const float*)(ws_ + WS_BA) + (size_t)(tok0 + lane) * 16;
        const float braw = BA[h], araw = BA[8 + h];
        const float beta = sigmoidf_(braw);
        const float sp = __logf(1.f + __expf(araw + dtb[h]));
        float G = -__expf(alog[h]) * sp;
#pragma unroll
        for (int d = 1; d < 64; d <<= 1) { const float t = bperm(G, lane >= d ? lane - d : lane); if (lane >= d) G += t; }
        glast = __int_as_float(__builtin_amdgcn_readlane(__float_as_int(G), 63));
        const float eg = __expf(G);
        sG[lane] = G; sBeta[lane] = beta; sBE[lane] = beta * eg; sEL[lane] = __expf(glast - G); sEG[lane] = eg;
        wsync();
    }
    const float eGlast = __expf(glast);
    bf16x8 qkP[2][4], vbT[4][2];
    bf16x8 kA[4][2];
    {
        SEC();
        { float v[4][8], rs[4]; conv_half<0>(xk, convw + 512 + h * 64, lane, v); l2norm_half(v, 1.f, rs, lane); write_transposed_h(X, v, rs, lane, 0); write_rowmajor_h(Y, v, rs, lane, 0); }
        { float v[4][8], rs[4]; conv_half<1>(xk, convw + 512 + h * 64, lane, v); l2norm_half(v, 1.f, rs, lane); write_transposed_h(X, v, rs, lane, 1); write_rowmajor_h(Y, v, rs, lane, 1); }
        wsync();
#pragma unroll
        for (int t = 0; t < 4; ++t)
#pragma unroll
            for (int s = 0; s < 2; ++s) { Kpark[(t * 2 + s) * 64] = __builtin_bit_cast(u32x4, read_frag(X, t, s, fr, g)); kA[t][s] = read_frag(Y, t, s, fr, g); }
        wsync();
    }
    u32x4 xq[11];
    {
        SEC();
        conv_load(P, tok0, first, PC_Q + h * 64, lane, xq);
        LAS float* AT = (LAS float*)X;
        f32x4 Gr[4], Br[4]; float Gc[4];
#pragma unroll
        for (int t = 0; t < 4; ++t) { Gr[t] = *(const LAS f32x4*)(sG + 16 * t + 4 * g); Br[t] = *(const LAS f32x4*)(sBeta + 16 * t + 4 * g); Gc[t] = sG[16 * t + fr]; }
#pragma unroll
        for (int nt = 0; nt < 4; ++nt)
#pragma unroll
            for (int mt = nt; mt < 4; ++mt) {
                f32x4 a = z4;
#pragma unroll
                for (int s = 0; s < 2; ++s) a = mfma16(kA[mt][s], kA[nt][s], a);
                const int j = 16 * nt + fr, m0 = 16 * mt + 4 * g;
                if ((mt >> 1) == (nt >> 1)) {
                    const int jl = j & 31, m0l = m0 & 31;
                    const int ms = (jl + 1) & ~3, ja = jl >> 2, jb = jl & 3, base = (nt >> 1) * ATL_BLK + 32 * jl - 4 * (2 * ja * (ja - 1) + ja * (jb + 1));
                    f32x4 o;
#pragma unroll
                    for (int r = 0; r < 4; ++r) o[r] = (m0 + r > j) ? Br[mt][r] * a[r] * __expf(Gr[mt][r] - Gc[nt]) : 0.f;
                    if (m0l >= ms) *(LAS f32x4*)(AT + base + m0l - ms) = o;
                } else {
                    f32x4 o;
#pragma unroll
                    for (int r = 0; r < 4; ++r) o[r] = Br[mt][r] * a[r] * __expf(Gr[mt][r] - Gc[nt]);
                    u32x2 w; w.x = pk_bf16(o[0], o[1]); w.y = pk_bf16(o[2], o[3]);
                    *(LAS u32x2*)(X + X_PT + (j * BPP + m0 - 32) * 2) = w;
                }
            }
    }
    u32x4 xv[11];
    {
        SEC();
        conv_load(P, tok0, first, PC_V + h * 64, lane, xv);
        { float v[4][8], rs[4]; conv_half<0>(xq, convw + h * 64, lane, v); l2norm_half(v, 0.125f, rs, lane); write_rowmajor_h(Y, v, rs, lane, 0); }
        { float v[4][8], rs[4]; conv_half<1>(xq, convw + h * 64, lane, v); l2norm_half(v, 0.125f, rs, lane); write_rowmajor_h(Y, v, rs, lane, 1); }
        wsync();
        f32x4 Gr[4]; float Gc[4];
#pragma unroll
        for (int t = 0; t < 4; ++t) { Gr[t] = *(const LAS f32x4*)(sG + 16 * t + 4 * g); Gc[t] = sG[16 * t + fr]; }
#pragma unroll
        for (int nt = 0; nt < 4; ++nt) {
            bf16x8 qBn[2];
#pragma unroll
            for (int s = 0; s < 2; ++s) { qBn[s] = read_frag(Y, nt, s, fr, g); Qb[(nt * 2 + s) * 64] = __builtin_bit_cast(u32x4, qBn[s]); }
            f32x4 tl[4];
#pragma unroll
            for (int mt = 0; mt < 4; ++mt) {
                f32x4 a = z4;
                if (mt <= nt) {
#pragma unroll
                    for (int s = 0; s < 2; ++s) a = mfma16(kA[mt][s], qBn[s], a);
                    const int cC = 16 * nt + fr, m0 = 16 * mt + 4 * g;
#pragma unroll
                    for (int r = 0; r < 4; ++r) a[r] = (m0 + r <= cC) ? a[r] * __expf(Gc[nt] - Gr[mt][r]) : 0.f;
                }
                tl[mt] = a;
            }
            qkP[0][nt] = pack2(tl[0], tl[1]); qkP[1][nt] = pack2(tl[2], tl[3]);
        }
        wsync();
    }
    {
        SEC();
        { float v[4][8]; conv_half<0>(xv, convw + 1024 + h * 64, lane, v); const f32x4 b0 = *(const LAS f32x4*)(sBeta + 8 * (lane >> 3)); const float rs[4] = {b0[0], b0[1], b0[2], b0[3]}; write_transposed_h(Y, v, rs, lane, 0); }
        { float v[4][8]; conv_half<1>(xv, convw + 1024 + h * 64, lane, v); const f32x4 b0 = *(const LAS f32x4*)(sBeta + 8 * (lane >> 3) + 4); const float rs[4] = {b0[0], b0[1], b0[2], b0[3]}; write_transposed_h(Y, v, rs, lane, 1); }
        wsync();
    }
    bf16x8 kT[4][2];
    {
        SEC();
        const u32x4* Kre_ = Kpark; asm volatile("" : "+v"(Kre_)); const __attribute__((address_space(1))) u32x4* Kre = (const __attribute__((address_space(1))) u32x4*)Kre_;
#pragma unroll
        for (int nt = 0; nt < 4; ++nt)
#pragma unroll
            for (int s = 0; s < 2; ++s) { vbT[nt][s] = read_frag(Y, nt, s, fr, g); kT[nt][s] = __builtin_bit_cast(bf16x8, Kre[(nt * 2 + s) * 64]); }
        wsync();
        const int li = lane & 31, hb = lane >> 5;
        float Tl[32];
        {
            const unsigned at0 = (unsigned)(size_t)X + (unsigned)hb * (ATL_BLK * 4);
#pragma unroll
            for (int j = 31; j >= 0; --j) {
                float a = (li == j) ? 1.f : 0.f;
                unsigned aj = at0;
                if (j < 30) asm volatile("" : "+v"(aj), "+v"(Tl[j + 2]));
                const LAS float* AT = (const LAS float*)aj;
#pragma unroll
                for (int m4 = at_mstart(j); m4 < 32; m4 += 4) {
                    const f32x4 av = *(const LAS f32x4*)(AT + atl_base(j) + m4 - at_mstart(j));
#pragma unroll
                    for (int e = 0; e < 4; ++e) if (m4 + e > j) a = __builtin_fmaf(-Tl[m4 + e], av[e], a);
                }
                Tl[j] = a;
            }
        }
        if (hb) {
#pragma unroll
            for (int q = 0; q < 4; ++q) { u32x4 w; w.x = pk_bf16(Tl[8 * q], Tl[8 * q + 1]); w.y = pk_bf16(Tl[8 * q + 2], Tl[8 * q + 3]); w.z = pk_bf16(Tl[8 * q + 4], Tl[8 * q + 5]); w.w = pk_bf16(Tl[8 * q + 6], Tl[8 * q + 7]);
                *(LAS u32x4*)(Y + Y_T22 + (li * BPP + 8 * q) * 2) = w; }
        } else {
#pragma unroll
            for (int c = 0; c < 32; ++c) *(LAS unsigned short*)(Y + Y_T11T + (c * BPP + li) * 2) = (unsigned short)(pk_bf16(Tl[c], 0.f) & 0xffffu);
        }
        wsync();
#pragma unroll
        for (int mt = 0; mt < 2; ++mt)
#pragma unroll
            for (int nt = 0; nt < 2; ++nt) {
                const f32x4 d = mfma16(read_frag32(X + X_PT, mt, fr, g), read_frag32(Y + Y_T22, nt, fr, g), z4);
                u32x2 w; w.x = pk_bf16(d[0], d[1]); w.y = pk_bf16(d[2], d[3]);
                *(LAS u32x2*)(Y + Y_Z + ((16 * nt + fr) * BPP + 16 * mt + 4 * g) * 2) = w;
            }
        wsync();
        f32x4 t21[2][2];
#pragma unroll
        for (int mt = 0; mt < 2; ++mt)
#pragma unroll
            for (int nt = 0; nt < 2; ++nt) t21[mt][nt] = -mfma16(read_frag32(Y + Y_T11T, mt, fr, g), read_frag32(Y + Y_Z, nt, fr, g), z4);
        wsync();
        const int cb = 32 * hb;
#pragma unroll
        for (int q = 0; q < 4; ++q) {
            const f32x4 s0 = *(const LAS f32x4*)(sBE + cb + 8 * q), s1 = *(const LAS f32x4*)(sBE + cb + 8 * q + 4);
            u32x4 w, w2;
            w.x = pk_bf16(Tl[8 * q], Tl[8 * q + 1]); w.y = pk_bf16(Tl[8 * q + 2], Tl[8 * q + 3]); w.z = pk_bf16(Tl[8 * q + 4], Tl[8 * q + 5]); w.w = pk_bf16(Tl[8 * q + 6], Tl[8 * q + 7]);
            w2.x = pk_bf16(Tl[8 * q] * s0[0], Tl[8 * q + 1] * s0[1]); w2.y = pk_bf16(Tl[8 * q + 2] * s0[2], Tl[8 * q + 3] * s0[3]);
            w2.z = pk_bf16(Tl[8 * q + 4] * s1[0], Tl[8 * q + 5] * s1[1]); w2.w = pk_bf16(Tl[8 * q + 6] * s1[2], Tl[8 * q + 7] * s1[3]);
            *(LAS u32x4*)(X + (lane * DLD + cb + 8 * q) * 2) = w;
            *(LAS u32x4*)(Y + (lane * DLD + cb + 8 * q) * 2) = w2;
            if (!hb) { const u32x4 zz = {0u, 0u, 0u, 0u}; *(LAS u32x4*)(X + (lane * DLD + 32 + 8 * q) * 2) = zz; *(LAS u32x4*)(Y + (lane * DLD + 32 + 8 * q) * 2) = zz; }
        }
#pragma unroll
        for (int mt = 0; mt < 2; ++mt)
#pragma unroll
            for (int nt = 0; nt < 2; ++nt) {
                const f32x4 sc = *(const LAS f32x4*)(sBE + 16 * mt + 4 * g);
                const f32x4 d = t21[mt][nt], d2 = d * sc;
                u32x2 w, w2; w.x = pk_bf16(d[0], d[1]); w.y = pk_bf16(d[2], d[3]); w2.x = pk_bf16(d2[0], d2[1]); w2.y = pk_bf16(d2[2], d2[3]);
                *(LAS u32x2*)(X + ((32 + 16 * nt + fr) * DLD + 16 * mt + 4 * g) * 2) = w;
                *(LAS u32x2*)(Y + ((32 + 16 * nt + fr) * DLD + 16 * mt + 4 * g) * 2) = w2;
            }
        wsync();
    }
    SEC();
    f32x4 ELr[4]; float EGc[4];
#pragma unroll
    for (int t = 0; t < 4; ++t) { ELr[t] = *(const LAS f32x4*)(sEL + 16 * t + 4 * g); EGc[t] = sEG[16 * t + fr]; }
    {
#pragma unroll
        for (int nt = 0; nt < 4; ++nt) {
            f32x4 Ut[4];
#pragma unroll
            for (int mt = 0; mt < 4; ++mt) { f32x4 a = z4;
#pragma unroll
                for (int s = 0; s < 2; ++s) a = mfma16(read_frag(X, mt, s, fr, g), vbT[nt][s], a);
                Ut[mt] = a; }
            bf16x8 Ub[2], Usb[2];
#pragma unroll
            for (int s = 0; s < 2; ++s) { Ub[s] = pack2(Ut[2 * s], Ut[2 * s + 1]); Usb[s] = pack2(Ut[2 * s] * ELr[2 * s], Ut[2 * s + 1] * ELr[2 * s + 1]); }
#pragma unroll
            for (int mt = 0; mt < 4; ++mt) { f32x4 a = z4;
#pragma unroll
                for (int s = 0; s < 2; ++s) a = mfma16(kT[mt][s], Usb[s], a);
                u32x2 nw; nw.x = pk_bf16(a[0], a[1]); nw.y = pk_bf16(a[2], a[3]); __builtin_nontemporal_store(nw, &Nb[(mt * 4 + nt) * 64]); }
#pragma unroll
            for (int n2 = 0; n2 < 4; ++n2) { f32x4 a = z4;
#pragma unroll
                for (int s = 0; s < 2; ++s) a = mfma16(Ub[s], qkP[s][n2], a);
                u32x2 ow; ow.x = pk_bf16(a[0], a[1]); ow.y = pk_bf16(a[2], a[3]); __builtin_nontemporal_store(ow, &Ob[(nt * 4 + n2) * 64]); }
            asm volatile("" ::: "memory");
        }
    }
    {
        u32x4 qbv[2][4];
        const u32x4* Qre_ = Qb; asm volatile("" : "+v"(Qre_)); const __attribute__((address_space(1))) u32x4* Qre = (const __attribute__((address_space(1))) u32x4*)Qre_;
#pragma unroll
        for (int s2 = 0; s2 < 2; ++s2)
#pragma unroll
            for (int nt = 0; nt < 4; ++nt) qbv[s2][nt] = Qre[(nt * 2 + s2) * 64];
#pragma unroll
        for (int s2 = 0; s2 < 2; ++s2) {
            bf16x8 Wb[2][2], Wsb[2][2];
#pragma unroll
            for (int w = 0; w < 2; ++w) {
                f32x4 Wt[4];
#pragma unroll
                for (int mt = 0; mt < 4; ++mt) { f32x4 a = z4;
#pragma unroll
                    for (int s = 0; s < 2; ++s) a = mfma16(read_frag(Y, mt, s, fr, g), kT[2 * s2 + w][s], a);
                    Wt[mt] = a; }
#pragma unroll
                for (int s = 0; s < 2; ++s) { Wb[w][s] = pack2(Wt[2 * s], Wt[2 * s + 1]); Wsb[w][s] = pack2(Wt[2 * s] * ELr[2 * s], Wt[2 * s + 1] * ELr[2 * s + 1]); }
            }
#pragma unroll
            for (int nt = 0; nt < 4; ++nt) {
                f32x4 mv[2], qv[2];
                const u32x4 qb = qbv[s2][nt];
#pragma unroll
                for (int w = 0; w < 2; ++w) {
                    f32x4 a = z4, q = z4;
#pragma unroll
                    for (int s = 0; s < 2; ++s) { a = mfma16(Wsb[w][s], kT[nt][s], a); q = mfma16(Wb[w][s], qkP[s][nt], q); }
                    const int dkp0 = 16 * (2 * s2 + w) + 4 * g, dk = 16 * nt + fr;
                    const unsigned q01 = w ? qb.z : qb.x, q23 = w ? qb.w : qb.y;
                    const float qg[4] = {bflo(q01), bfhi(q01), bflo(q23), bfhi(q23)};
#pragma unroll
                    for (int r = 0; r < 4; ++r) { mv[w][r] = ((dkp0 + r == dk) ? eGlast : 0.f) - a[r]; qv[w][r] = qg[r] * EGc[nt] - q[r]; }
                }
                __builtin_nontemporal_store(__builtin_bit_cast(u32x4, pack2(mv[0], mv[1])), &Mb[(nt * 2 + s2) * 64]);
                __builtin_nontemporal_store(__builtin_bit_cast(u32x4, pack2(qv[0], qv[1])), &Qb[(nt * 2 + s2) * 64]);
            }
            asm volatile("" ::: "memory");
        }
    }
}
#undef SEC
template <int W>
DI void pool_item(const bf16_t* P, bf16_t* PM, int tb, int c8) {
    const int t0 = tb * 8, tin = t0 & (L_ - 1);
    u32x4 x[W + 7];
#pragma unroll
    for (int r = 0; r < W + 7; ++r) {
        const int rel = r - (W - 1);
        u32x4 v = {0u, 0u, 0u, 0u};
        if (tin + rel >= 0) v = *(const u32x4*)(P + (size_t)(t0 + rel) * NP + PC_U + 8 * c8);
        x[r] = v;
    }
    float s[8];
#pragma unroll
    for (int e = 0; e < 8; ++e) s[e] = 0.f;
#pragma unroll
    for (int r = 0; r < W - 1; ++r) { s[0] += bflo(x[r].x); s[1] += bfhi(x[r].x); s[2] += bflo(x[r].y); s[3] += bfhi(x[r].y); s[4] += bflo(x[r].z); s[5] += bfhi(x[r].z); s[6] += bflo(x[r].w); s[7] += bfhi(x[r].w); }
#pragma unroll
    for (int i = 0; i < 8; ++i) {
        const u32x4 c = x[i + W - 1];
        const float u0[8] = {bflo(c.x), bfhi(c.x), bflo(c.y), bfhi(c.y), bflo(c.z), bfhi(c.z), bflo(c.w), bfhi(c.w)};
#pragma unroll
        for (int e = 0; e < 8; ++e) s[e] += u0[e];
        const int cnt = (tin + i + 1 < W) ? tin + i + 1 : W;
        const float inv = 1.f / (float)cnt;
        u32x4 o; o.x = pk_bf16(s[0] * inv - u0[0], s[1] * inv - u0[1]); o.y = pk_bf16(s[2] * inv - u0[2], s[3] * inv - u0[3]);
        o.z = pk_bf16(s[4] * inv - u0[4], s[5] * inv - u0[5]); o.w = pk_bf16(s[6] * inv - u0[6], s[7] * inv - u0[7]);
        *(u32x4*)(PM + (size_t)(t0 + i) * 512 + 8 * c8) = o;
        const u32x4 d = x[i];
        s[0] -= bflo(d.x); s[1] -= bfhi(d.x); s[2] -= bflo(d.y); s[3] -= bfhi(d.y); s[4] -= bflo(d.z); s[5] -= bfhi(d.z); s[6] -= bflo(d.w); s[7] -= bfhi(d.w);
    }
}
DI void pool_prep(const Frame& F) {
    const bf16_t* P = (const bf16_t*)(F.ws + WS_P); bf16_t* PM = (bf16_t*)(F.ws + WS_PM);
    for (int wi = F.bid * 8 + F.wid; wi < 4 * (T_ / 32); wi += F.G * 8) {
        const int grp = wi & 3, tb = (wi >> 2) * 4 + (F.lane >> 4), c8 = grp * 16 + (F.lane & 15);
        if (grp == 0) pool_item<2>(P, PM, tb, c8);
        else if (grp == 1) pool_item<4>(P, PM, tb, c8);
        else if (grp == 2) pool_item<8>(P, PM, tb, c8);
        else pool_item<16>(P, PM, tb, c8);
    }
}

constexpr int SC_NS = 14, SC_SLOT = 10240, SC_FLAGS = SC_NS * SC_SLOT;
DI void delta_scan(const Frame& F) {
    const int lane = F.lane;
    LAS unsigned char* ring = F.lds;
    volatile LAS int* ready = (volatile LAS int*)(F.lds + SC_FLAGS); volatile LAS int* consumed = ready + 64;
    if (F.tid < 65) ready[F.tid] = 0;
    __syncthreads();
    unsigned char* dl = F.ws + WS_DELTA;
    for (int job = F.bid; job < 256; job += F.G) {
        const int chain = (job & 7) * 8 + (job >> 5), nt = (job >> 3) & 3;
        const u32x4* Mb = (const u32x4*)(dl + DL_M) + (size_t)chain * 8 * 64 + lane;
        const u32x2* Nb = (const u32x2*)(dl + DL_N) + (size_t)chain * 16 * 64 + lane;
        if (F.wid == 0) {
            u32x4* Sb = (u32x4*)(dl + DL_S) + (size_t)chain * 8 * 64 + lane;
            f32x4 S[4];
#pragma unroll
            for (int m = 0; m < 4; ++m) S[m] = (f32x4){0.f, 0.f, 0.f, 0.f};
            u32x4 Mq[8]; u32x2 Nr[4]; int nready;
            { unsigned sp = 0; while (ready[0] == 0) { __builtin_amdgcn_s_sleep(1); if (++sp > (1u << 22)) break; } }
            asm volatile("" ::: "memory");
#pragma unroll
            for (int f = 0; f < 8; ++f) Mq[f] = *(const LAS u32x4*)(ring + lane * 16 + f * 1024);
#pragma unroll
            for (int m = 0; m < 4; ++m) Nr[m] = *(const LAS u32x2*)(ring + 8192 + lane * 8 + m * 512);
            nready = ready[1];
            wsync();
            if (lane == 0) *consumed = 1;
            for (int c = 0; c < 64; ++c) {
                bf16x8 Sf[2];
#pragma unroll
                for (int s = 0; s < 2; ++s) { Sf[s] = pack2(S[2 * s], S[2 * s + 1]); __builtin_nontemporal_store(__builtin_bit_cast(u32x4, Sf[s]), &Sb[((size_t)c * 64 * 8 + nt * 2 + s) * 64]); }
#pragma unroll
                for (int m = 0; m < 4; ++m) { f32x4 a = {bflo(Nr[m].x), bfhi(Nr[m].x), bflo(Nr[m].y), bfhi(Nr[m].y)};
#pragma unroll
                    for (int s = 0; s < 2; ++s) a = mfma16(__builtin_bit_cast(bf16x8, Mq[m * 2 + s]), Sf[s], a);
                    S[m] = a; }
                __builtin_amdgcn_sched_barrier(0);
                if (c + 1 < 64) {
                    if (nready == 0) { unsigned sp = 0; while (ready[c + 1] == 0) { __builtin_amdgcn_s_sleep(1); if (++sp > (1u << 22)) break; } }
                    asm volatile("" ::: "memory");
                    const LAS unsigned char* slot = ring + ((c + 1) % SC_NS) * SC_SLOT;
#pragma unroll
                    for (int f = 0; f < 8; ++f) Mq[f] = *(const LAS u32x4*)(slot + lane * 16 + f * 1024);
#pragma unroll
                    for (int m = 0; m < 4; ++m) Nr[m] = *(const LAS u32x2*)(slot + 8192 + lane * 8 + m * 512);
                    nready = ready[(c + 2) & 63];
                    wsync();
                    if (lane == 0) *consumed = c + 2;
                }
            }
        } else {
            for (int c = F.wid - 1; c < 64; c += 7) {
                u32x4 Mq[8]; u32x2 Nq[4];
#pragma unroll
                for (int f = 0; f < 8; ++f) Mq[f] = Mb[((size_t)c * 64 * 8 + f) * 64];
#pragma unroll
                for (int m = 0; m < 4; ++m) Nq[m] = Nb[((size_t)c * 64 * 16 + m * 4 + nt) * 64];
                { unsigned sp = 0; while (c - *consumed >= SC_NS) { __builtin_amdgcn_s_sleep(1); if (++sp > (1u << 22)) break; } }
                asm volatile("" ::: "memory");
                LAS unsigned char* slot = ring + (c % SC_NS) * SC_SLOT + lane * 16;
#pragma unroll
                for (int f = 0; f < 8; ++f) *(LAS u32x4*)(slot + f * 1024) = Mq[f];
#pragma unroll
                for (int m = 0; m < 4; ++m) *(LAS u32x2*)(ring + (c % SC_NS) * SC_SLOT + 8192 + lane * 8 + m * 512) = Nq[m];
                wsync();
                if (lane == 0) ready[c] = 1;
            }
        }
    }
}

struct DoutIn { bf16x8 Sf[4][2], Qf[4][2]; u32x2 Ot[16]; };
DI void delta_out_load(const Frame& F, int lane, int unit, DoutIn& d) {
    unsigned char* dl = F.ws + WS_DELTA;
    const u32x4* Qb = (const u32x4*)(dl + DL_Q) + (size_t)unit * 8 * 64 + lane;
    const u32x4* Sb = (const u32x4*)(dl + DL_S) + (size_t)dl_cmajor(unit) * 8 * 64 + lane;
    const u32x2* Ob = (const u32x2*)(dl + DL_O) + (size_t)unit * 16 * 64 + lane;
#pragma unroll
    for (int t = 0; t < 4; ++t)
#pragma unroll
        for (int s = 0; s < 2; ++s) { d.Sf[t][s] = __builtin_bit_cast(bf16x8, Sb[(t * 2 + s) * 64]); d.Qf[t][s] = __builtin_bit_cast(bf16x8, Qb[(t * 2 + s) * 64]); }
#pragma unroll
    for (int t = 0; t < 16; ++t) d.Ot[t] = Ob[t * 64];
}
DI void dout_z_issue(const Frame& F, int lane, int unit, u32x4 (&zr)[8]) {
    const int bh = unit >> 6, c = unit & 63, b = bh >> 3, h = bh & 7;
    const bf16_t* P = (const bf16_t*)(F.ws + WS_P) + ((size_t)b * L_ + c * 64) * NP + PC_Z + h * 64 + 8 * (lane & 7);
#pragma unroll
    for (int p = 0; p < 8; ++p) zr[p] = *(const u32x4*)(P + (size_t)(8 * p + (lane >> 3)) * NP);
}
DI void dout_z_put(LAS unsigned char* img, int lane, const u32x4 (&zr)[8]) {
#pragma unroll
    for (int p = 0; p < 8; ++p) *(LAS u32x4*)(img + ((8 * p + (lane >> 3)) * DLD + 8 * (lane & 7)) * 2) = zr[p];
}
DI void delta_out_compute(const Frame& F, int lane, int unit, const DoutIn& d, LAS unsigned char* img, const f32x4 (&dn)[4]) {
    asm volatile("" : "+v"(lane));
    const int fr = lane & 15, g = lane >> 4;
    const int bh = unit >> 6, c = unit & 63, b = bh >> 3, h = bh & 7;
    const long tok0 = (long)b * L_ + c * 64;
    bf16_t* OA = (bf16_t*)(F.ws + WS_OA);
#pragma unroll
    for (int nt = 0; nt < 4; ++nt) {
        LAS unsigned char* zrow = img + ((16 * nt + fr) * DLD + 4 * g) * 2;
        u32x2 zz[4];
#pragma unroll
        for (int mt = 0; mt < 4; ++mt) zz[mt] = *(const LAS u32x2*)(zrow + 32 * mt);
        f32x4 o[4]; float ss = 0.f;
#pragma unroll
        for (int mt = 0; mt < 4; ++mt) { const u32x2 ob = d.Ot[mt * 4 + nt]; f32x4 a = {bflo(ob.x), bfhi(ob.x), bflo(ob.y), bfhi(ob.y)};
#pragma unroll
            for (int s = 0; s < 2; ++s) a = mfma16(d.Sf[mt][s], d.Qf[nt][s], a);
            o[mt] = a; ss += a[0] * a[0] + a[1] * a[1] + a[2] * a[2] + a[3] * a[3]; }
        { const auto r16 = __builtin_amdgcn_permlane16_swap(__float_as_uint(ss), __float_as_uint(ss), false, false); ss = __uint_as_float(r16[0]) + __uint_as_float(r16[1]); }
        { const auto r32 = __builtin_amdgcn_permlane32_swap(__float_as_uint(ss), __float_as_uint(ss), false, false); ss = __uint_as_float(r32[0]) + __uint_as_float(r32[1]); }
        const float rn = __builtin_amdgcn_rsqf(ss * (1.f / 64.f) + EPS);
#pragma unroll
        for (int mt = 0; mt < 4; ++mt) {
            const float z[4] = {bflo(zz[mt].x), bfhi(zz[mt].x), bflo(zz[mt].y), bfhi(zz[mt].y)};
            float y[4];
#pragma unroll
            for (int r = 0; r < 4; ++r) y[r] = o[mt][r] * rn * dn[mt][r] * siluf_(z[r]);
            u32x2 w; w.x = pk_bf16(y[0], y[1]); w.y = pk_bf16(y[2], y[3]);
            *(LAS u32x2*)(zrow + 32 * mt) = w;
        }
    }
    wsync();
#pragma unroll
    for (int p = 0; p < 8; ++p) {
        const int row = 8 * p + (lane >> 3);
        const u32x4 v = *(const LAS u32x4*)(img + (row * DLD + 8 * (lane & 7)) * 2);
        *(u32x4*)(OA + (size_t)(tok0 + row) * 512 + h * 64 + 8 * (lane & 7)) = v;
    }
}
DI void delta_out(const Frame& F) {
    const int u0 = F.bid * 8 + F.wid;
    LAS unsigned char* imgA = F.lds + F.wid * DW_BYTES; LAS unsigned char* imgB = imgA + 9216;
    for (int u = u0; u < 4096; u += F.G * 8 * 2) {
        const int u2 = u + F.G * 8; const bool has2 = u2 < 4096;
        int lane = F.lane; asm volatile("" : "+v"(lane));
        f32x4 dn[4];
#pragma unroll
        for (int mt = 0; mt < 4; ++mt) dn[mt] = *(const f32x4*)(F.in[I_DNN] + 16 * mt + 4 * (lane >> 4));
        u32x4 zA[8], zB[8];
        dout_z_issue(F, lane, u, zA); dout_z_issue(F, lane, has2 ? u2 : u, zB);
        asm volatile("" ::: "memory");
        DoutIn A, B;
        delta_out_load(F, lane, u, A);
        dout_z_put(imgA, lane, zA); dout_z_put(imgB, lane, zB);
        asm volatile("" ::: "memory");
        __builtin_amdgcn_sched_barrier(0);
        delta_out_load(F, lane, has2 ? u2 : u, B);
        __builtin_amdgcn_sched_barrier(0);
        wsync();
        delta_out_compute(F, lane, u, A, imgA, dn);
        if (has2) delta_out_compute(F, lane, u2, B, imgB, dn);
        wsync();
    }
}

constexpr int RT_PITCH = 36;
constexpr int RT_CNT = 1024 * RT_PITCH * 4;
DI void router_pick(float (&a)[32], int lane, float brt, int tl, LAS int* lcount, LAS int* rec_e, LAS int* rec_s, LAS float* rec_w, LAS float* scr) {
#pragma unroll
    for (int i = 0; i < 16; ++i) { const auto r = __builtin_amdgcn_permlane32_swap(__float_as_uint(a[i]), __float_as_uint(a[i + 16]), false, false); a[i] = __uint_as_float(r[0]) + __uint_as_float(r[1]); }
#pragma unroll
    for (int i = 0; i < 8; ++i) { const auto r = __builtin_amdgcn_permlane16_swap(__float_as_uint(a[i]), __float_as_uint(a[i + 8]), false, false); a[i] = __uint_as_float(r[0]) + __uint_as_float(r[1]); }
#define RT_STEP(mask, half) { const bool up = (lane & (mask)) != 0; _Pragma("unroll") for (int i = 0; i < (half); ++i) { const float keep = up ? a[i + (half)] : a[i], send = up ? a[i] : a[i + (half)]; a[i] = keep + __shfl_xor(send, (mask)); } }
    RT_STEP(8, 4) RT_STEP(4, 2) RT_STEP(2, 1)
#undef RT_STEP
    const float val = a[0] + __shfl_xor(a[0], 1) + brt;
    LAS float* sv = scr; LAS float* sl = scr + 32;
    const int e = lane >> 1, odd = lane & 1;
    if (!odd) sv[e] = val;
    wsync();
    f32x4 q[4];
#pragma unroll
    for (int j = 0; j < 4; ++j) q[j] = *(const LAS f32x4*)(sv + 16 * odd + 4 * j);
    wsync();
    int rk = 0;
#pragma unroll
    for (int j = 0; j < 16; ++j) { const float vj = q[j >> 2][j & 3]; const int jj = j + 16 * odd; rk += ((vj > val) || (vj == val && jj < e)) ? 1 : 0; }
    const int rank = rk + __builtin_amdgcn_update_dpp(0, rk, 0xB1, 0xf, 0xf, false);
    if (rank < 4 && !odd) { sl[2 * rank] = val; ((LAS int*)sl)[2 * rank + 1] = e; }
    wsync();
    const f32x4 s01 = *(const LAS f32x4*)sl, s23 = *(const LAS f32x4*)(sl + 4);
    wsync();
    const float e1 = __expf(s01[2] - s01[0]), e2 = __expf(s23[0] - s01[0]), e3 = __expf(s23[2] - s01[0]);
    const float inv = 1.f / (1.f + e1 + e2 + e3);
    if (lane < 4) {
        const float exk = lane == 0 ? 1.f : (lane == 1 ? e1 : (lane == 2 ? e2 : e3));
        const int ek = __float_as_int(lane == 0 ? s01[1] : (lane == 1 ? s01[3] : (lane == 2 ? s23[1] : s23[3])));
        const float wk = exk * inv;
        const int slot = atomicAdd((int*)(lcount + ek), 1);
        rec_e[tl * 4 + lane] = ek; rec_s[tl * 4 + lane] = slot; rec_w[tl * 4 + lane] = wk;
    }
}
DI void p7_router(const Frame& F) {
    LAS float* W = (LAS float*)F.lds;
    LAS int* lcount = (LAS int*)(F.lds + RT_CNT); LAS int* lbase = lcount + 32; LAS int* rec_e = lbase + 32; LAS int* rec_s = rec_e + 512; LAS float* rec_w = (LAS float*)(rec_s + 512);
    const float* x1 = F.in[I_X]; const bf16_t* dx = (const bf16_t*)(F.ws + WS_PM); unsigned char* h2 = F.ws + WS_H;
    int* gcount = (int*)(F.ws + WS_CTL + CW_CNT); int* list = (int*)(F.ws + WS_LIST); float* topw = (float*)(F.ws + WS_TOPW);
    const int lane = F.lane;
    {   f32x4 wst[16];
#pragma unroll
        for (int j = 0; j < 16; ++j) { const int i = F.tid + 512 * j; wst[j] = *(const f32x4*)(F.in[I_WR] + (i >> 3) * 32 + (i & 7) * 4); }
#pragma unroll
        for (int j = 0; j < 16; ++j) { const int i = F.tid + 512 * j, k = i >> 3, q = i & 7; *(LAS f32x4*)(W + ((k & 3) * 256 + (k >> 2)) * RT_PITCH + q * 4) = wst[j]; } }
    const float brt = F.in[I_BR][lane >> 1];
    for (int chunk = F.bid; chunk < T_ / 128; chunk += F.G) {
        { int tq = F.tid; asm volatile("" : "+v"(tq)); if (tq < 32) lcount[tq] = 0; }
        __syncthreads();
        const int tokc = chunk * 128;
        f32x4 vn[2][4]; u32x2 dn2[2][4];
        const float* xa = x1 + (size_t)(tokc + F.wid * 16) * 1024 + 4 * lane; bf16_t* da = (bf16_t*)dx + (size_t)(tokc + F.wid * 16) * 1024 + 4 * lane; unsigned char* ha = h2 + (size_t)(tokc + F.wid * 16) * 1024 + 4 * lane;
#pragma unroll
        for (int t = 0; t < 2; ++t)
#pragma unroll
            for (int i = 0; i < 4; ++i) { dn2[t][i] = *(const u32x2*)(da + t * 1024 + 256 * i); vn[t][i] = *(const f32x4*)(xa + t * 1024 + 256 * i); }
        for (int it = 0; it < 8; ++it) {
            if (it == 4 && F.wid >= 4) __builtin_amdgcn_s_setprio(2);
            const int tl0 = F.wid * 16 + it * 2;
            f32x4 v[2][4]; float rr[2];
            f32x4 gf[4];
            { int lg = lane; asm volatile("" : "+v"(lg));
#pragma unroll
              for (int i = 0; i < 4; ++i) gf[i] = *(const f32x4*)(F.in[I_GFFN] + 4 * (lg + 64 * i)); }
#pragma unroll
            for (int t = 0; t < 2; ++t) { float ss = 0.f;
#pragma unroll
                for (int i = 0; i < 4; ++i) { const u32x2 d2 = dn2[t][i]; v[t][i] = vn[t][i];
                    v[t][i][0] += bflo(d2.x); v[t][i][1] += bfhi(d2.x); v[t][i][2] += bflo(d2.y); v[t][i][3] += bfhi(d2.y); ss += v[t][i][0] * v[t][i][0] + v[t][i][1] * v[t][i][1] + v[t][i][2] * v[t][i][2] + v[t][i][3] * v[t][i][3];
                    u32x2 xw; xw.x = pk_bf16(v[t][i][0], v[t][i][1]); xw.y = pk_bf16(v[t][i][2], v[t][i][3]);
                    *(u32x2*)(da + t * 1024 + 256 * i) = xw;
                    v[t][i] = v[t][i] * gf[i]; }
                ss = wave_sum_dpp(ss);
                rr[t] = __builtin_amdgcn_rsqf(ss * (1.f / 1024.f) + EPS); }
            unsigned char* hc = ha;
            { const int adv = (it < 7) ? 2048 : 0; xa += adv; da += adv; ha += adv;
#pragma unroll
              for (int t = 0; t < 2; ++t)
#pragma unroll
                for (int i = 0; i < 4; ++i) { dn2[t][i] = *(const u32x2*)(da + t * 1024 + 256 * i); vn[t][i] = *(const f32x4*)(xa + t * 1024 + 256 * i); } }
            f32x2 p0[16], p1[16];
#pragma unroll
            for (int e = 0; e < 16; ++e) { p0[e] = (f32x2){0.f, 0.f}; p1[e] = (f32x2){0.f, 0.f}; }
            f32x4 wc[4], wn[4];
            int lw = lane; asm volatile("" : "+v"(lw));
            const LAS float* Wl = W + lw * RT_PITCH;
#pragma unroll
            for (int q = 0; q < 4; ++q) wc[q] = *(const LAS f32x4*)(Wl + 4 * q);
#pragma unroll
            for (int i = 0; i < 4; ++i) {
                f32x4 hn[2];
#pragma unroll
                for (int t = 0; t < 2; ++t) { hn[t] = v[t][i] * rr[t];
                    *(unsigned*)(hc + t * 1024 + 256 * i) = pk4_fp8(hn[t][0] * SC_H2, hn[t][1] * SC_H2, hn[t][2] * SC_H2, hn[t][3] * SC_H2); }
#pragma unroll
                for (int e = 0; e < 4; ++e) {
                    const f32x2 hp = {hn[0][e], hn[1][e]};
#pragma unroll
                    for (int hf = 0; hf < 2; ++hf) {
                        const int nx = (i * 4 + e) * 2 + hf + 1;
                        if (nx < 32) { const LAS float* wrn = Wl + (((nx >> 1) & 3) * 256 + (nx >> 3) * 64) * RT_PITCH + (nx & 1) * 16;
#pragma unroll
                            for (int q = 0; q < 4; ++q) wn[q] = *(const LAS f32x4*)(wrn + 4 * q); }
                        __builtin_amdgcn_sched_barrier(0);
#pragma unroll
                        for (int q = 0; q < 4; ++q)
#pragma unroll
                            for (int z = 0; z < 2; ++z) { const f32x2 w2 = z ? __builtin_shufflevector(wc[q], wc[q], 2, 3) : __builtin_shufflevector(wc[q], wc[q], 0, 1);
                                asm("v_pk_fma_f32 %0, %1, %2, %0 op_sel_hi:[1,0,1]" : "+v"(p0[8 * hf + 2 * q + z]) : "v"(w2), "v"(hp));
                                asm("v_pk_fma_f32 %0, %1, %2, %0 op_sel:[0,1,0] op_sel_hi:[1,1,1]" : "+v"(p1[8 * hf + 2 * q + z]) : "v"(w2), "v"(hp)); }
                        __builtin_amdgcn_sched_barrier(0);
#pragma unroll
                        for (int q = 0; q < 4; ++q) wc[q] = wn[q];
                    }
                }
            }
            float a0[32], a1[32];
#pragma unroll
            for (int e = 0; e < 16; ++e) { a0[2 * e] = p0[e].x; a0[2 * e + 1] = p0[e].y; a1[2 * e] = p1[e].x; a1[2 * e + 1] = p1[e].y; }
            { int lo = lane; asm volatile("" : "+v"(lo));
              LAS float* scr = (LAS float*)(F.lds + RT_CNT + 6400) + F.wid * 96;
              router_pick(a0, lo, brt, tl0, lcount, rec_e, rec_s, rec_w, scr);
              router_pick(a1, lo, brt, tl0 + 1, lcount, rec_e, rec_s, rec_w, scr + 48); }
        }
        __builtin_amdgcn_s_setprio(0);
        __syncthreads();
        { int tq = F.tid; asm volatile("" : "+v"(tq)); if (tq < 32) lbase[tq] = atomicAdd(gcount + tq, lcount[tq]); }
        __syncthreads();
        { int idx = F.tid; asm volatile("" : "+v"(idx)); const int e = rec_e[idx];
          list[e * LISTCAP + lbase[e] + rec_s[idx]] = tokc * 4 + idx; topw[tokc * 4 + idx] = rec_w[idx]; }
        __syncthreads();
    }
}

DI void moe_table(const Frame& F, LAS MoeTbl* tb) {
    const int* gcount = (const int*)(F.ws + WS_CTL + CW_CNT);
    if (F.tid < NE) tb->cnt[F.tid] = gcount[F.tid];
    __syncthreads();
    if (F.tid == 0) { int acc = 0; for (int e = 0; e < NE; ++e) { tb->rts[e] = acc; acc += (tb->cnt[e] + 255) >> 8; } tb->rts[NE] = acc; }
    __syncthreads();
}

DI void p10_final(const Frame& F) {
    const unsigned char* yk = F.ws + WS_DELTA; const float* topw = (const float*)(F.ws + WS_TOPW); float* out = F.out; const bf16_t* dx = (const bf16_t*)(F.ws + WS_PM);
    const int lane = F.lane;
    f32x4 gf[4];
#pragma unroll
    for (int i = 0; i < 4; ++i) gf[i] = *(const f32x4*)(F.in[I_GFIN] + 4 * (lane + 64 * i));
    for (int tok0 = (F.bid * 8 + F.wid) * 2; tok0 < T_; tok0 += F.G * 8 * 2) {
        f32x4 v[2][4]; unsigned y[2][4][4]; f32x4 tw[2];
#pragma unroll
        for (int r = 0; r < 2; ++r) { tw[r] = *(const f32x4*)(topw + (size_t)(tok0 + r) * 4) * (1.f / SC_Y);
#pragma unroll
            for (int i = 0; i < 4; ++i) { const u32x2 d2 = *(const u32x2*)(dx + (size_t)(tok0 + r) * 1024 + 4 * (lane + 64 * i));
                v[r][i] = (f32x4){bflo(d2.x), bfhi(d2.x), bflo(d2.y), bfhi(d2.y)}; }
#pragma unroll
            for (int k = 0; k < 4; ++k)
#pragma unroll
                for (int i = 0; i < 4; ++i) y[r][k][i] = *(const unsigned*)(yk + ((size_t)(tok0 + r) * 4 + k) * 1024 + 4 * (lane + 64 * i)); }
#pragma unroll
        for (int r = 0; r < 2; ++r) {
#pragma unroll
            for (int k = 0; k < 4; ++k)
#pragma unroll
                for (int i = 0; i < 4; ++i) { const f32x2 lo = __builtin_amdgcn_cvt_pk_f32_fp8(y[r][k][i], false), hi = __builtin_amdgcn_cvt_pk_f32_fp8(y[r][k][i], true);
                    v[r][i][0] += tw[r][k] * lo.x; v[r][i][1] += tw[r][k] * lo.y; v[r][i][2] += tw[r][k] * hi.x; v[r][i][3] += tw[r][k] * hi.y; }
            float ss = 0.f;
#pragma unroll
            for (int i = 0; i < 4; ++i) ss += v[r][i][0] * v[r][i][0] + v[r][i][1] * v[r][i][1] + v[r][i][2] * v[r][i][2] + v[r][i][3] * v[r][i][3];
            ss = wave_sum(ss);
            const float rn = __builtin_amdgcn_rsqf(ss * (1.f / 1024.f) + EPS);
#pragma unroll
            for (int i = 0; i < 4; ++i) *(f32x4*)(out + (size_t)(tok0 + r) * 1024 + 4 * (lane + 64 * i)) = v[r][i] * rn * gf[i];
        }
    }
}

__global__ void __launch_bounds__(512, 2) fwd(Params prm) {
    extern __shared__ __attribute__((aligned(16))) unsigned char lds_raw[];
#define T0() (wid_k == 0 && __builtin_amdgcn_mbcnt_hi(~0u, __builtin_amdgcn_mbcnt_lo(~0u, 0u)) == 0u)
#define FRAME() Frame F; F.lds = (LAS unsigned char*)lds_raw; { int t_ = wid_k * 64 + (int)__builtin_amdgcn_mbcnt_hi(~0u, __builtin_amdgcn_mbcnt_lo(~0u, 0u)); asm volatile("" : "+v"(t_)); F.tid = t_; } F.lane = F.tid & 63; F.wid = __builtin_amdgcn_readfirstlane(F.tid >> 6); \
    F.G = gridDim.x; F.bid = blockIdx.x; _Pragma("unroll") for (int i_ = 0; i_ < 20; ++i_) F.in[i_] = prm.in[i_]; F.out = prm.out; F.ws = prm.ws; unsigned char* ws = F.ws; (void)ws;
    LAS unsigned char* const ldsb = (LAS unsigned char*)lds_raw;
    const int wid_k = __builtin_amdgcn_readfirstlane(threadIdx.x >> 6);
    if (threadIdx.x == 0) *(LAS u32x4*)(ldsb + LDS_BARW) = (u32x4){0u, 0u, 0u, 0u};
    __syncthreads();
    XcdBarrier bar; bar.bar = (unsigned*)(prm.ws + WS_CTL + CW_BAR); bar.x = 0; bar.st = (volatile LAS unsigned*)(ldsb + LDS_BARW);
    if (N_LAUNCHES == 1) bar = xcd_barrier_post((unsigned*)(prm.ws + WS_CTL + CW_BAR), (volatile LAS unsigned*)(ldsb + LDS_BARW), T0());
    const int lo = prm.ph_lo, hi = prm.ph_hi;
#ifndef PHASE_MASK
#define PHASE_MASK 0x7ff
#endif
#define IN(k) (((PHASE_MASK >> (k)) & 1) && lo <= (k) && (k) < hi)
#define SEAM(k) do { if (IN(k) && IN((k) + 1)) xcd_barrier(bar, T0()); } while (0)
#ifndef REPEAT_MASK
#define REPEAT_MASK 0
#endif
#define REP(k) for (int rep_ = 0; rep_ < (((REPEAT_MASK >> (k)) & 1) ? 2 : 1); ++rep_)
    LAS MoeTbl* tb = (LAS MoeTbl*)(ldsb + pg8::STAGE_BYTES);

    REP(0) if (IN(0)) { if (rep_) xcd_barrier(bar, T0()); FRAME(); moe_weights(F, F.bid, F.G); p0_prologue(F); }
    SEAM(0);
    REP(1) if (IN(1)) { if (rep_) xcd_barrier(bar, T0());
        FRAME();
        DenseSched S; S.A = (const char*)(ws + WS_H); S.Bt = (const char*)(ws + WS_WIN); S.K = 1024; S.so.init(T_, NP, F.G, F.bid); S.mixgate = 1;
        EpiP E{(bf16_t*)(ws + WS_P)};
        pg8::gemm_phase(F.lds, F.tid, 1024, S, E);
    }
    SEAM(1);
    REP(2) if (IN(2)) { if (rep_) xcd_barrier(bar, T0());
        { FRAME(); pool_prep(F); }
        { FRAME();
          LAS unsigned char* wl = F.lds + F.wid * DW_BYTES;
          for (int u = F.bid * 8 + F.wid; u < 4096; u += F.G * 8) { if (u >= F.G * 8 && F.wid >= 4) __builtin_amdgcn_s_setprio(2); delta_prep_unit(F.ws, F.in[I_CONVW], F.in[I_ALOG], F.in[I_DTB], F.bid * 8 + F.wid, wl, u); }
          __builtin_amdgcn_s_setprio(0); }
    }
    SEAM(2);
    REP(3) if (IN(3)) { if (rep_) xcd_barrier(bar, T0()); FRAME(); delta_scan(F); }
    SEAM(3);
    REP(4) if (IN(4)) { if (rep_) xcd_barrier(bar, T0()); FRAME(); delta_out(F); }
    SEAM(4);
    REP(5) if (IN(5)) { if (rep_) xcd_barrier(bar, T0());
        FRAME();
        UpSched S; S.A0 = (const char*)(ws + WS_OA); S.A1 = (const char*)(ws + WS_PM); S.B0 = (const char*)(ws + WS_WA); S.B1 = (const char*)(ws + WS_WB); S.so.init(T_, 1024, F.G, F.bid);
        EpiUp E{(const bf16_t*)(ws + WS_P), (bf16_t*)(ws + WS_H)};
        pg8::gemm_phase(F.lds, F.tid, 512, S, E);
    }
    SEAM(5);
    REP(6) if (IN(6)) { if (rep_) xcd_barrier(bar, T0());
        FRAME();
        DenseSched S; S.A = (const char*)(ws + WS_H); S.Bt = (const char*)(ws + WS_WOUT); S.K = 1024; S.so.init(T_, 1024, F.G, F.bid); S.mixgate = 0;
        EpiStoreBf16 E{(bf16_t*)(ws + WS_PM), 1024};
        pg8::gemm_phase(F.lds, F.tid, 1024, S, E);
    }
    SEAM(6);
    REP(7) if (IN(7)) { if (rep_) xcd_barrier(bar, T0()); FRAME(); p7_router(F); }
    SEAM(7);
    REP(8) if (IN(8)) { if (rep_) xcd_barrier(bar, T0());
        FRAME();
        moe_table(F, tb);
        MoeSched S; S.A = (const char*)(ws + WS_H); S.Bt = (const char*)(ws + WS_WGU); S.list = (const int*)(ws + WS_LIST); S.tb = tb; S.K = 512; S.NT = 8; S.RG = 4; S.bid = F.bid;
        S.bstride = (size_t)2048 * 1024; S.gather = true;
        EpiGateUp E{ws + WS_P, F.in[I_BGU]};
        pg8::gemm_phase<EpiGateUp, MoeSched, true>(F.lds, F.tid, 512, S, E, E8_W, E8_H2);
    }
    SEAM(8);
    REP(9) if (IN(9)) { if (rep_) xcd_barrier(bar, T0());
        FRAME();
        moe_table(F, tb);
        MoeSched S; S.A = (const char*)(ws + WS_P); S.Bt = (const char*)(ws + WS_WD); S.list = (const int*)(ws + WS_LIST); S.tb = tb; S.K = 512; S.NT = 4; S.RG = 8; S.bid = F.bid;
        S.bstride = (size_t)1024 * 1024; S.gather = false;
        EpiDown E{ws + WS_DELTA, F.in[I_BD], (const int*)(ws + WS_LIST), tb};
        pg8::gemm_phase<EpiDown, MoeSched, true>(F.lds, F.tid, 512, S, E, E8_W, E8_ACT);
    }
    SEAM(9);
    REP(10) if (IN(10)) { if (rep_) xcd_barrier(bar, T0()); FRAME(); p10_final(F); }
#undef IN
#undef SEAM
}

extern "C" void kernel_launch(void* const* d_in, const int* in_sizes, int n_in, void* d_out, int out_size, void* d_ws, size_t ws_size, hipStream_t stream) {
    static int ready = 0;
    if (!ready) {
        if (n_in != 20 || out_size != T_ * D_ || ws_size < WS_END) { fprintf(stderr, "kernel_launch: unexpected shapes (n_in %d out %d ws %zu)\n", n_in, out_size, ws_size); ready = -1; return; }
        if (hipFuncSetAttribute((const void*)fwd, hipFuncAttributeMaxDynamicSharedMemorySize, LDS_BYTES) != hipSuccess) { fprintf(stderr, "kernel_launch: hipFuncSetAttribute failed\n"); ready = -1; return; }
        int per_cu = 0;
        if (hipOccupancyMaxActiveBlocksPerMultiprocessor(&per_cu, (const void*)fwd, 512, LDS_BYTES) != hipSuccess || per_cu < 1) fprintf(stderr, "kernel_launch: occupancy query says %d\n", per_cu);
        (void)hipGetLastError();
        ready = 1;
    }
    if (ready < 0) return;
    const int grid = 256;
    (void)hipMemsetAsync((char*)d_ws + WS_CTL, 0, CTL_BYTES, stream);
    Params p{};
    for (int i = 0; i < 20; ++i) p.in[i] = (const float*)d_in[i];
    p.out = (float*)d_out; p.ws = (unsigned char*)d_ws;
    if (N_LAUNCHES == 1) { p.ph_lo = 0; p.ph_hi = NPHASE; hipLaunchKernelGGL(fwd, dim3(grid), dim3(512), LDS_BYTES, stream, p); }
    else for (int k = 0; k < NPHASE; ++k) { p.ph_lo = k; p.ph_hi = k + 1; hipLaunchKernelGGL(fwd, dim3(grid), dim3(512), LDS_BYTES, stream, p); }
}
```
